# Optimizing an MI355X kernel written in HIP

```python
import jax, jax.numpy as jnp
from jax import lax
import numpy as np

D_MODEL = 1024
BATCH = 8
SEQ = 2048
DEPTH = 1
DEC_BATCH = 128
DEC_SEQ = 1
PAST_LEN = 16384
PAGE_SIZE = 128

D_A = D_MODEL // 2
G_A = 4
GC_A = D_A // G_A
WINDOWS = (2, 4, 8, 16)
POOL_BUF = max(WINDOWS) - 1
D_B = D_MODEL // 2
G_B = 4
C_B = D_B // G_B
CHUNK = 128
D_IN = 2 * D_A + 3 * D_B + 2 * D_MODEL
EPS = 1e-6

kernel_name = "pool_sgu_hybrid_decoder_step"


def rmsnorm(x, g):
    xf = x.astype(jnp.float32)
    r = lax.rsqrt(jnp.mean(xf * xf, axis=-1, keepdims=True) + EPS)
    return (xf * r).astype(x.dtype) * g


def layernorm(x, g, b):
    xf = x.astype(jnp.float32)
    mu = jnp.mean(xf, axis=-1, keepdims=True)
    var = jnp.mean(jnp.square(xf - mu), axis=-1, keepdims=True)
    return ((xf - mu) * lax.rsqrt(var + EPS)).astype(x.dtype) * g + b


def pool_mixer(a, prefix, pos0, pool_w, pool_b, pool_scale):
    B, T, _ = a.shape
    P = POOL_BUF
    ext = jnp.concatenate([prefix, a], axis=1)
    cs = jnp.cumsum(ext.astype(jnp.float32), axis=1)
    cs0 = jnp.concatenate([jnp.zeros((B, 1, D_A), jnp.float32), cs], axis=1)
    pos = pos0 + jnp.arange(T)
    outs = []
    for k, w in enumerate(WINDOWS):
        sl = slice(k * GC_A, (k + 1) * GC_A)
        s = cs0[:, P + 1:P + 1 + T, sl] - cs0[:, P + 1 - w:P + 1 - w + T, sl]
        cnt = jnp.minimum(pos + 1, w).astype(jnp.float32)
        outs.append(s / cnt[None, :, None])
    pooled = jnp.concatenate(outs, axis=-1).astype(a.dtype) - a
    y = jnp.einsum('btgc,gcd->btgd', pooled.reshape(B, T, G_A, GC_A), pool_w) + pool_b
    return y.reshape(B, T, D_A) * pool_scale, ext[:, -P:]


def spatial_gate(u, v, ln_g, ln_b, sgu_w, sgu_b):
    u = jax.nn.gelu(u, approximate=False)
    v = layernorm(jax.nn.gelu(v, approximate=False), ln_g, ln_b)
    B, T, _ = v.shape
    Lc = min(T, CHUNK)
    n = T // Lc
    vr = v.reshape(B, n, Lc, G_B, C_B)
    tril = jnp.tril(jnp.ones((Lc, Lc), dtype=bool))
    W = jnp.where(tril[None], sgu_w[:, :Lc, :Lc], 0.0).astype(v.dtype)
    s = jnp.einsum('gts,bnsgc->bntgc', W, vr) + sgu_b[:, :Lc].T[:, :, None]
    return u * s.reshape(B, T, D_B), v[:, T - Lc:]


def layer(x, c, prefix, pos0, w_ada, b_ada, norm_gain, w_in, pool_w, pool_b, pool_scale,
          sgu_ln_g, sgu_ln_b, sgu_w, sgu_b, w_branch_a, w_branch_b, w_out):
    mod = jax.nn.silu(c) @ w_ada + b_ada
    shift, scale, gate = jnp.split(mod, 3, axis=-1)
    h = rmsnorm(x, norm_gain) * (1.0 + scale[:, None]) + shift[:, None]
    z = h @ w_in
    cuts = np.cumsum([D_A, D_A, D_B, D_B, D_B, D_MODEL])
    a, ga, u, v, gb, ma, mb = jnp.split(z, [int(i) for i in cuts], axis=-1)
    ya, new_pool = pool_mixer(a, prefix, pos0, pool_w, pool_b, pool_scale)
    ya = ya * jax.nn.silu(ga)
    yb, new_v = spatial_gate(u, v, sgu_ln_g, sgu_ln_b, sgu_w, sgu_b)
    yb = yb * jax.nn.silu(gb)
    merged = jax.nn.sigmoid(ma) * (ya @ w_branch_a) + jax.nn.sigmoid(mb) * (yb @ w_branch_b)
    x = x + gate[:, None] * (merged @ w_out)
    return x, new_pool, new_v


def setup_inputs(seed: int = 0) -> dict:
    key = jax.random.key(seed)
    ks = jax.random.split(key, 24)
    f = jnp.float32
    nrm = lambda k, s, sc: jax.random.normal(k, s, f) * sc
    return {
        "x_prompt": nrm(ks[0], (BATCH, SEQ, D_MODEL), 1.0),
        "x_sample": nrm(ks[1], (DEC_BATCH, DEC_SEQ, D_MODEL), 1.0),
        "state_pool": nrm(ks[2], (DEPTH, DEC_BATCH, POOL_BUF, D_A), 0.6),
        "c_prompt": nrm(ks[3], (BATCH, D_MODEL), 1.0),
        "c_sample": nrm(ks[4], (DEC_BATCH, D_MODEL), 1.0),
        "w_ada": nrm(ks[5], (DEPTH, D_MODEL, 3 * D_MODEL), 0.5 * D_MODEL ** -0.5),
        "b_ada": nrm(ks[6], (DEPTH, 3 * D_MODEL), 0.02),
        "norm_gain": 1.0 + nrm(ks[7], (DEPTH, D_MODEL), 0.05),
        "w_in": nrm(ks[8], (DEPTH, D_MODEL, D_IN), D_MODEL ** -0.5),
        "pool_w": nrm(ks[9], (DEPTH, G_A, GC_A, GC_A), GC_A ** -0.5),
        "pool_b": nrm(ks[10], (DEPTH, G_A, GC_A), 0.02),
        "pool_scale": 1.0 + nrm(ks[11], (DEPTH, D_A), 0.1),
        "sgu_ln_g": 1.0 + nrm(ks[12], (DEPTH, D_B), 0.05),
        "sgu_ln_b": nrm(ks[13], (DEPTH, D_B), 0.02),
        "sgu_w": nrm(ks[14], (DEPTH, G_B, CHUNK, CHUNK), CHUNK ** -0.5),
        "sgu_b": 1.0 + nrm(ks[15], (DEPTH, G_B, CHUNK), 0.1),
        "w_branch_a": nrm(ks[16], (DEPTH, D_A, D_MODEL), D_A ** -0.5),
        "w_branch_b": nrm(ks[17], (DEPTH, D_B, D_MODEL), D_B ** -0.5),
        "w_out": nrm(ks[18], (DEPTH, D_MODEL, D_MODEL), D_MODEL ** -0.5),
        "final_gain": 1.0 + nrm(ks[19], (D_MODEL,), 0.05),
    }


def reference(x_prompt, x_sample, state_pool, c_prompt, c_sample, w_ada, b_ada, norm_gain, w_in,
              pool_w, pool_b, pool_scale, sgu_ln_g, sgu_ln_b, sgu_w, sgu_b, w_branch_a, w_branch_b,
              w_out, final_gain):
    xp, xs = x_prompt, x_sample
    pool_p, pool_s, v_p, v_s = [], [], [], []
    zero_prefix = jnp.zeros((BATCH, POOL_BUF, D_A), x_prompt.dtype)
    for l in range(DEPTH):
        params = (w_ada[l], b_ada[l], norm_gain[l], w_in[l], pool_w[l], pool_b[l], pool_scale[l],
                  sgu_ln_g[l], sgu_ln_b[l], sgu_w[l], sgu_b[l], w_branch_a[l], w_branch_b[l], w_out[l])
        xp, npp, nvp = layer(xp, c_prompt, zero_prefix, 0, *params)
        xs, nps, nvs = layer(xs, c_sample, state_pool[l], PAST_LEN, *params)
        pool_p.append(npp); pool_s.append(nps); v_p.append(nvp); v_s.append(nvs)
    y_prompt = rmsnorm(xp, final_gain)
    y_sample = rmsnorm(xs, final_gain)
    return (y_prompt, y_sample, jnp.stack(pool_p), jnp.stack(pool_s), jnp.stack(v_p), jnp.stack(v_s))
```

```cpp
#include <hip/hip_runtime.h>
#include <hip/hip_cooperative_groups.h>
#include <cstdio>
namespace cg = cooperative_groups;

namespace pg8 {
#define PG8_LAS __attribute__((address_space(3)))
typedef unsigned short bf16_t;
typedef short bf16x8 __attribute__((ext_vector_type(8)));
typedef float f32x4 __attribute__((ext_vector_type(4)));
typedef unsigned u32x4 __attribute__((ext_vector_type(4)));
constexpr int BM = 256, BK = 64, HALF = 128, HTB = HALF * BK * 2  , STAGE_BYTES = 8 * HTB, NXCD = 8, WGM = 8;

__host__ __device__ __forceinline__ int lds_byte(int r, int c) { const int st = (r >> 4) * 2 + (c >> 5), rr = r & 15, cc = c & 31, ob = rr * 64 + cc * 2; return st * 1024 + (ob ^ (((ob >> 9) & 1) << 5)); }
__host__ __device__ __forceinline__ void stage_rc(int b, int& R, int& C) { const int st = b / 1024, sb = b % 1024, swz = sb ^ (((sb >> 9) & 1) << 5); R = (st >> 1) * 16 + swz / 64; C = (st & 1) * 32 + (swz % 64) / 2; }
__host__ __device__ __forceinline__ int perm32(int rho) { const int n = rho >> 4, i = rho & 15; return 8 * (i >> 2) + 4 * n + (i & 3); }

struct Unit { int pm, pn; };
struct Gemm { const bf16_t* A; const bf16_t* Bt; int M, N, K; };

struct StaticOrder {
    int nM, nN, nwg, G, c;
    __host__ __device__ void init(int M, int N, int G_, int c_) { nM = M / BM; nN = N / BM; nwg = nM * nN; G = G_; c = c_; }
    __host__ __device__ bool next(int i, Unit& u) const {
        const long L = (long)i * G + c; if (L >= nwg) return false;
        int wgid = (int)L; { const int q = nwg / NXCD, r = nwg % NXCD, xcd = wgid % NXCD, off = wgid / NXCD; wgid = (xcd < r ? xcd * (q + 1) : r * (q + 1) + (xcd - r) * q) + off; }
        const int nig = WGM * nN, gid = wgid / nig, fm = gid * WGM, gsz = (nM - fm) < WGM ? (nM - fm) : WGM;
        u.pm = fm + ((wgid % nig) % gsz); u.pn = (wgid % nig) / gsz; return true;
    }
    __device__ __forceinline__ void a_ready(const Unit&) const {}
    __device__ __forceinline__ void done(const Unit&) const {}
};
__device__ __forceinline__ unsigned cvt_pk_bf16(float lo, float hi) { unsigned r; asm volatile("v_cvt_pk_bf16_f32 %0, %1, %2" : "=v"(r) : "v"(lo), "v"(hi)); return r; }
typedef float f32x2 __attribute__((ext_vector_type(2)));
__device__ __forceinline__ f32x2 gelu_pk(f32x2 v) {
    const f32x2 av = __builtin_elementwise_abs(v), d = av * 0.2316418882f + 1.0f;
    f32x2 t; t.x = __builtin_amdgcn_rcpf(d.x); t.y = __builtin_amdgcn_rcpf(d.y);
    f32x2 q = t * 0.5307027145f + (-0.7265760135f); q = q * t + 0.7107068705f; q = q * t + (-0.142248368f); q = q * t + 0.127414796f; q = q * t;
    const f32x2 s = (v * v) * (-0.72134752044f);
    f32x2 e; e.x = __builtin_amdgcn_exp2f(s.x); e.y = __builtin_amdgcn_exp2f(s.y);
    const f32x2 m = v * (q * e), r = v - m;
    f32x2 o; o.x = v.x < 0.f ? m.x : r.x; o.y = v.y < 0.f ? m.y : r.y; return o;
}

#define PG8_KBODY { \
            const bool last = (t == nt - 2); \
            const char* a1 = cA + (size_t)(t + 1) * kstep; \
            const char* a2 = last ? nA : cA + (size_t)(t + 2) * kstep; const char* b2 = last ? nB : cB + (size_t)(t + 2) * kstep; \
            const char* a3 = a2 + kstep; const char* b3 = b2 + kstep; \
            if (last && has_next) S.a_ready(nxt); \
            PG8_LDB(B0, 0, 0); PG8_SCHED; PG8_LDA(At, 0, 0); PG8_STAGE(PG8_SA(1, 1), a1 + hstep, voffA); \
            PG8_WAIT_L(8); PG8_BAR; PG8_WAIT_L(0); PG8_MMA(0, 0, At, B0); PG8_BAR; PG8_SCHED; \
            PG8_LDB(B1, 0, 1); PG8_STAGE(PG8_SB(0, 0), b2, voffB); \
            PG8_BAR; PG8_WAIT_L(0); PG8_MMA(0, 1, At, B1); PG8_BAR; \
            PG8_LDA(At, 0, 1); PG8_STAGE(PG8_SA(0, 0), a2, voffA); \
            PG8_BAR; PG8_WAIT_L(0); PG8_MMA(1, 0, At, B0); PG8_BAR; PG8_SCHED; \
            PG8_STAGE(PG8_SB(0, 1), b2 + hstep, voffB); \
            PG8_WAIT_V(6); PG8_BAR; PG8_MMA(1, 1, At, B1); PG8_BAR; \
            PG8_LDB(B0, 1, 0); PG8_SCHED; PG8_LDA(At, 1, 0); PG8_STAGE(PG8_SA(0, 1), a2 + hstep, voffA); \
            PG8_WAIT_L(8); PG8_BAR; PG8_WAIT_L(0); PG8_MMA(0, 0, At, B0); PG8_BAR; PG8_SCHED; \
            PG8_LDB(B1, 1, 1); PG8_STAGE(PG8_SB(1, 0), b3, voffB); \
            PG8_BAR; PG8_WAIT_L(0); PG8_MMA(0, 1, At, B1); PG8_BAR; \
            PG8_LDA(At, 1, 1); PG8_STAGE(PG8_SA(1, 0), a3, voffA); \
            PG8_BAR; PG8_WAIT_L(0); PG8_MMA(1, 0, At, B0); PG8_BAR; PG8_SCHED; \
            PG8_STAGE(PG8_SB(1, 1), b3 + hstep, voffB); \
            PG8_WAIT_V(6); PG8_BAR; PG8_MMA(1, 1, At, B1); PG8_BAR; \
        }
template <class Epi, class Sched>
__device__ __forceinline__ void gemm_phase(PG8_LAS unsigned char* lds, const Gemm g, const Sched& S, const Epi& E) {
    int tid_ = threadIdx.x; asm volatile("" : "+v"(tid_));
    const int tid = tid_, wid = __builtin_amdgcn_readfirstlane(tid >> 6), lane = tid & 63, wr = wid >> 2, wc = wid & 3, fr = lane & 15, fq = lane >> 4;
    const int K = g.K, nt = K / BK;
    unsigned voffA[2], voffB[2];
#pragma unroll
    for (int i = 0; i < 2; ++i) { int R, C; stage_rc(tid * 16 + i * 8192, R, C); const int Rb = Epi::PERM ? ((R & ~31) + perm32(R & 31)) : R;
        voffA[i] = (unsigned)(R * K + C) * 2u; voffB[i] = (unsigned)(Rb * K + C) * 2u; }
    const size_t kstep = (size_t)(BK * 2);
    const size_t hstep = (size_t)HALF * K * 2;
    const size_t tstep = 2 * hstep;
    const unsigned ldsw = (unsigned)wid * 1024u;
    const int aoff = lds_byte(wr * 64 + fr, fq * 8), boff = lds_byte(wc * 32 + fr, fq * 8);
#define PG8_SA(b, h) (((b) * 2 + (h)) * HTB)
#define PG8_SB(b, h) ((4 + (b) * 2 + (h)) * HTB)
#define PG8_STAGE(bufoff, gbase, voff) do { _Pragma("unroll") for (int _i = 0; _i < 2; ++_i) \
        __builtin_amdgcn_global_load_lds((const unsigned*)((const char*)(gbase) + (voff)[_i]), (PG8_LAS unsigned*)(lds + (bufoff) + ldsw + _i * 8192), 16, 0, 0); } while (0)
#define PG8_LDA(dst, b, h) do { _Pragma("unroll") for (int m = 0; m < 4; ++m) _Pragma("unroll") for (int k = 0; k < 2; ++k) dst[m][k] = *(const PG8_LAS bf16x8*)(lds + PG8_SA(b, h) + aoff + m * 2048 + k * 1024); } while (0)
#define PG8_LDB(dst, b, h) do { _Pragma("unroll") for (int n = 0; n < 2; ++n) _Pragma("unroll") for (int k = 0; k < 2; ++k) dst[n][k] = *(const PG8_LAS bf16x8*)(lds + PG8_SB(b, h) + boff + n * 2048 + k * 1024); } while (0)
#define PG8_MMA(ai, bj, At, Bt) do { __builtin_amdgcn_s_setprio(1); _Pragma("unroll") for (int m = 0; m < 4; ++m) _Pragma("unroll") for (int n = 0; n < 2; ++n) _Pragma("unroll") for (int k = 0; k < 2; ++k) \
        acc[ai][bj][m][n] = __builtin_amdgcn_mfma_f32_16x16x32_bf16(Bt[n][k], At[m][k], acc[ai][bj][m][n], 0, 0, 0); __builtin_amdgcn_s_setprio(0); } while (0)
#define PG8_WAIT_V(n) asm volatile("s_waitcnt vmcnt(" #n ")" ::: "memory")
#define PG8_WAIT_L(n) asm volatile("s_waitcnt lgkmcnt(" #n ")" ::: "memory")
#define PG8_BAR __builtin_amdgcn_s_barrier()
#define PG8_SCHED __builtin_amdgcn_sched_barrier(0)
    Unit cur, nxt; int ui = 0;
    if (!S.next(0, cur)) return;
    f32x4 acc[2][2][4][2];
#pragma unroll
    for (int a = 0; a < 2; ++a)
#pragma unroll
        for (int b = 0; b < 2; ++b)
#pragma unroll
            for (int m = 0; m < 4; ++m)
#pragma unroll
                for (int n = 0; n < 2; ++n) acc[a][b][m][n] = (f32x4){0.f, 0.f, 0.f, 0.f};
    bf16x8 At[4][2], B0[2][2], B1[2][2];
    const char* cA = (const char*)g.A + (size_t)cur.pm * tstep; const char* cB = (const char*)g.Bt + (size_t)cur.pn * tstep;
    S.a_ready(cur);
    PG8_STAGE(PG8_SB(0, 0), cB, voffB); PG8_STAGE(PG8_SA(0, 0), cA, voffA); PG8_STAGE(PG8_SB(0, 1), cB + hstep, voffB); PG8_STAGE(PG8_SA(0, 1), cA + hstep, voffA);
    if (wr == 1) PG8_BAR;
    PG8_WAIT_V(4); PG8_BAR;
    PG8_STAGE(PG8_SB(1, 0), cB + kstep, voffB); PG8_STAGE(PG8_SA(1, 0), cA + kstep, voffA); PG8_STAGE(PG8_SB(1, 1), cB + hstep + kstep, voffB);
    PG8_WAIT_V(6); PG8_BAR;
    for (;;) {
        const bool has_next = S.next(ui + 1, nxt);
        const char* nA = has_next ? (const char*)g.A + (size_t)nxt.pm * tstep : cA; const char* nB = has_next ? (const char*)g.Bt + (size_t)nxt.pn * tstep : cB;
        if constexpr (Epi::MIDK) {
            for (int t = 0; t < (nt >> 1); t += 2) PG8_KBODY
            E.mid(acc, cur, wr, wc, fr, fq);
            for (int t = (nt >> 1); t < nt; t += 2) PG8_KBODY
        } else {
            for (int t = 0; t < nt; t += 2) PG8_KBODY
        }
        if constexpr (!Epi::AFTER_DRAIN) { E(acc, cur, wr, wc, fr, fq); S.done(cur); }
        if (!has_next) break;
#pragma unroll
        for (int a = 0; a < 2; ++a)
#pragma unroll
            for (int b = 0; b < 2; ++b)
#pragma unroll
                for (int m = 0; m < 4; ++m)
#pragma unroll
                    for (int n = 0; n < 2; ++n) acc[a][b][m][n] = (f32x4){0.f, 0.f, 0.f, 0.f};
        cur = nxt; cA = nA; cB = nB; ++ui;
    }
    PG8_WAIT_V(0);
    if (wr == 0) PG8_BAR;
    PG8_BAR;
    if constexpr (Epi::AFTER_DRAIN) { E.fused(acc, cur, wr, wc, fr, fq, lds, wid, lane); S.done(cur); }
#undef PG8_KBODY
#undef PG8_SA
#undef PG8_SB
#undef PG8_STAGE
#undef PG8_LDA
#undef PG8_LDB
#undef PG8_MMA
#undef PG8_WAIT_V
#undef PG8_WAIT_L
#undef PG8_BAR
#undef PG8_SCHED
}
}

using namespace pg8;
#define LAS PG8_LAS
typedef unsigned u32x2 __attribute__((ext_vector_type(2)));

constexpr int D = 1024, NB = 8, SEQ = 2048, MPR = NB * SEQ, MS = 128, MT = MPR + MS, MPAD = 16640;
constexpr int DIN = 4608, NMOD = 3072, NROWC = 136, KS_MOD = 8;
constexpr int OFF_A = 0, OFF_GA = 512, OFF_U = 1024, OFF_V = 1536, OFF_GB = 2048, OFF_MA = 2560, OFF_MB = 3584;
constexpr size_t O_YP = 0, O_YS = 16777216, O_PP = 16908288, O_PS = 16969728, O_VP = 17952768, O_VS = 18477056;
constexpr size_t WS_MODP = 0;
constexpr size_t WS_GATE = WS_MODP + 13369344;
constexpr size_t WS_HB = WS_GATE + 557056;
constexpr size_t WS_WIN = WS_HB + 34078720;
constexpr size_t WS_WAB = WS_WIN + 9437184;
constexpr size_t WS_WO = WS_WAB + 2097152;
constexpr size_t WS_PW = WS_WO + 2097152;
constexpr size_t WS_SW = WS_PW + 131072;
constexpr size_t WS_Z = WS_SW + 131072;
constexpr size_t WS_YAB = WS_Z + 153354240;
constexpr size_t WS_RP = WS_YAB + 34078720;
constexpr size_t WS_XS = WS_RP + 1048576;
constexpr size_t WS_END = WS_XS + 524288;
constexpr int LDS_BYTES = 131072;
constexpr int NTHR = 512;

struct Args { const float* in[20]; float* out; unsigned char* ws; };

__device__ __forceinline__ unsigned pk_bf16(float lo, float hi) { unsigned r; asm("v_cvt_pk_bf16_f32 %0, %1, %2" : "=v"(r) : "v"(lo), "v"(hi)); return r; }
__device__ __forceinline__ float bf_lo(unsigned u) { return __uint_as_float(u << 16); }
__device__ __forceinline__ float bf_hi(unsigned u) { return __uint_as_float(u & 0xffff0000u); }
__device__ __forceinline__ float sigmoid_f(float x) { return __builtin_amdgcn_rcpf(1.0f + __expf(-x)); }
__device__ __forceinline__ float silu_f(float x) { return x * sigmoid_f(x); }
__device__ __forceinline__ float wave_sum(float v) {
    v += __shfl_xor(v, 1); v += __shfl_xor(v, 2); v += __shfl_xor(v, 4); v += __shfl_xor(v, 8); v += __shfl_xor(v, 16); v += __shfl_xor(v, 32); return v;
}
__device__ __forceinline__ f32x4 act4(f32x4 v, int act) {
    if (act == 1) { v[0] = silu_f(v[0]); v[1] = silu_f(v[1]); v[2] = silu_f(v[2]); v[3] = silu_f(v[3]); }
    else if (act == 2) { const f32x2 a = gelu_pk((f32x2){v[0], v[1]}), b = gelu_pk((f32x2){v[2], v[3]}); v = (f32x4){a.x, a.y, b.x, b.y}; }
    else if (act == 3) { v[0] = sigmoid_f(v[0]); v[1] = sigmoid_f(v[1]); v[2] = sigmoid_f(v[2]); v[3] = sigmoid_f(v[3]); }
    return v;
}

struct EpiZ {
    static constexpr bool PERM = true, AFTER_DRAIN = false, MIDK = false;
    bf16_t* Z;
    __device__ __forceinline__ void mid(f32x4 (&)[2][2][4][2], const Unit&, int, int, int, int) const {}
    __device__ __forceinline__ void fused(f32x4 (&)[2][2][4][2], const Unit&, int, int, int, int, LAS unsigned char*, int, int) const {}
    __device__ __forceinline__ void operator()(const f32x4 (&acc)[2][2][4][2], const Unit& u, int wr, int wc, int fr, int fq) const {
        const int pn = u.pn;
        const int act = pn < 2 ? 0 : pn < 4 ? 1 : pn < 8 ? 2 : pn < 10 ? 1 : 3;
        const int row0 = u.pm * BM + wr * 64 + fr, col0 = pn * BM + wc * 32 + 8 * fq;
#pragma unroll
        for (int ai = 0; ai < 2; ++ai)
#pragma unroll
            for (int m = 0; m < 4; ++m) {
                const int row = row0 + ai * HALF + m * 16;
                if (row < MT) {
                    bf16_t* rowp = Z + (size_t)row * DIN + col0;
                    if (act == 3) {
                        f32x4 r[2], sb[2];
#pragma unroll
                        for (int n = 0; n < 2; ++n)
#pragma unroll
                            for (int j = 0; j < 4; ++j) { const float b = fmaxf(sigmoid_f(acc[ai][1][m][n][j]), 1e-6f); sb[n][j] = b; r[n][j] = sigmoid_f(acc[ai][0][m][n][j]) * __builtin_amdgcn_rcpf(b); }
                        u32x4 w; w.x = pk_bf16(r[0][0], r[0][1]); w.y = pk_bf16(r[0][2], r[0][3]); w.z = pk_bf16(r[1][0], r[1][1]); w.w = pk_bf16(r[1][2], r[1][3]);
                        *(u32x4*)(rowp) = w;
                        w.x = pk_bf16(sb[0][0], sb[0][1]); w.y = pk_bf16(sb[0][2], sb[0][3]); w.z = pk_bf16(sb[1][0], sb[1][1]); w.w = pk_bf16(sb[1][2], sb[1][3]);
                        *(u32x4*)(rowp + HALF) = w;
                    } else {
#pragma unroll
                        for (int bj = 0; bj < 2; ++bj) {
                            const f32x4 v0 = act4(acc[ai][bj][m][0], act), v1 = act4(acc[ai][bj][m][1], act);
                            u32x4 w; w.x = pk_bf16(v0[0], v0[1]); w.y = pk_bf16(v0[2], v0[3]); w.z = pk_bf16(v1[0], v1[1]); w.w = pk_bf16(v1[2], v1[3]);
                            *(u32x4*)(rowp + bj * HALF) = w;
                        }
                    }
                }
            }
    }
};

struct EpiMerged {
    static constexpr bool PERM = true, AFTER_DRAIN = false, MIDK = true;
    const bf16_t* Z; bf16_t* O;
    __device__ __forceinline__ void fused(f32x4 (&)[2][2][4][2], const Unit&, int, int, int, int, LAS unsigned char*, int, int) const {}
    __device__ __forceinline__ void mid(f32x4 (&acc)[2][2][4][2], const Unit& u, int wr, int wc, int fr, int fq) const {
        const char* zb = (const char*)Z;
        const unsigned off0 = ((unsigned)(u.pm * BM + wr * 64 + fr) * DIN + OFF_MA + u.pn * 512 + wc * 32 + 8 * fq) * 2u;
#pragma unroll
        for (int ai = 0; ai < 2; ++ai)
#pragma unroll
            for (int m = 0; m < 4; ++m) {
                u32x4 r[2];
#pragma unroll
                for (int bj = 0; bj < 2; ++bj) r[bj] = *(const u32x4*)(zb + off0 + (unsigned)((ai * HALF + m * 16) * DIN + bj * 256) * 2u);
#pragma unroll
                for (int bj = 0; bj < 2; ++bj) {
                    const u32x4 a = r[bj];
                    acc[ai][bj][m][0] *= (f32x4){bf_lo(a.x), bf_hi(a.x), bf_lo(a.y), bf_hi(a.y)};
                    acc[ai][bj][m][1] *= (f32x4){bf_lo(a.z), bf_hi(a.z), bf_lo(a.w), bf_hi(a.w)};
                }
                asm volatile("" ::: "memory");
            }
    }
    __device__ __forceinline__ void operator()(const f32x4 (&acc)[2][2][4][2], const Unit& u, int wr, int wc, int fr, int fq) const {
        const char* zb = (const char*)Z;
        const unsigned off0 = ((unsigned)(u.pm * BM + wr * 64 + fr) * DIN + OFF_MA + u.pn * 512 + 128 + wc * 32 + 8 * fq) * 2u;
        const int row0 = u.pm * BM + wr * 64 + fr, col0 = u.pn * BM + wc * 32 + 8 * fq;
#pragma unroll
        for (int ai = 0; ai < 2; ++ai)
#pragma unroll
            for (int m = 0; m < 4; ++m) {
                bf16_t* rowp = O + (size_t)(row0 + ai * HALF + m * 16) * D + col0;
#pragma unroll
                for (int bj = 0; bj < 2; ++bj) {
                    const u32x4 b = *(const u32x4*)(zb + off0 + (unsigned)((ai * HALF + m * 16) * DIN + bj * 256) * 2u);
                    const f32x4 v0 = acc[ai][bj][m][0], v1 = acc[ai][bj][m][1];
                    u32x4 w;
                    w.x = pk_bf16(v0[0] * bf_lo(b.x), v0[1] * bf_hi(b.x)); w.y = pk_bf16(v0[2] * bf_lo(b.y), v0[3] * bf_hi(b.y));
                    w.z = pk_bf16(v1[0] * bf_lo(b.z), v1[1] * bf_hi(b.z)); w.w = pk_bf16(v1[2] * bf_lo(b.w), v1[3] * bf_hi(b.w));
                    *(u32x4*)(rowp + bj * HALF) = w;
                }
                if (m & 1) asm volatile("" ::: "memory");
            }
    }
};

struct EpiFinal {
    static constexpr bool PERM = false, AFTER_DRAIN = true, MIDK = false;
    const float* x; const float* gate; const float* fgain; float* rp; float* y; const float* xs; float* ys;
    __device__ __forceinline__ void mid(f32x4 (&)[2][2][4][2], const Unit&, int, int, int, int) const {}
    __device__ __forceinline__ void operator()(const f32x4 (&)[2][2][4][2], const Unit&, int, int, int, int) const {}
    __device__ __forceinline__ void fused(f32x4 (&acc)[2][2][4][2], const Unit& u, int wr, int wc, int fr, int fq, LAS unsigned char* lds, int wid, int lane) const {
        const int col0 = u.pn * BM + wc * 32 + 4 * fq, b = u.pm >> 3;
        {
            f32x4 g[2][2];
#pragma unroll
            for (int bj = 0; bj < 2; ++bj)
#pragma unroll
                for (int n = 0; n < 2; ++n) g[bj][n] = *(const f32x4*)(gate + b * D + col0 + bj * HALF + n * 16);
#pragma unroll
            for (int ai = 0; ai < 2; ++ai)
#pragma unroll
                for (int m = 0; m < 4; ++m) {
                    const int row = u.pm * BM + ai * HALF + wr * 64 + m * 16 + fr;
                    const float* xr = x + (size_t)row * D + col0;
                    float ss = 0.f;
#pragma unroll
                    for (int bj = 0; bj < 2; ++bj)
#pragma unroll
                        for (int n = 0; n < 2; ++n) {
                            const f32x4 xv = *(const f32x4*)(xr + bj * HALF + n * 16);
                            const f32x4 v = xv + g[bj][n] * acc[ai][bj][m][n];
                            acc[ai][bj][m][n] = v;
                            ss += (v[0] * v[0] + v[1] * v[1]) + (v[2] * v[2] + v[3] * v[3]);
                        }
                    ss += __shfl_xor(ss, 16); ss += __shfl_xor(ss, 32);
                    if (fq == 0) rp[(size_t)row * 16 + u.pn * 4 + wc] = ss;
                    asm volatile("" ::: "memory");
                }
        }
        cg::this_grid().sync();
        {
            f32x4 fg[2][2];
#pragma unroll
            for (int bj = 0; bj < 2; ++bj)
#pragma unroll
                for (int n = 0; n < 2; ++n) fg[bj][n] = *(const f32x4*)(fgain + col0 + bj * HALF + n * 16);
#pragma unroll
            for (int ai = 0; ai < 2; ++ai)
#pragma unroll
                for (int m = 0; m < 4; ++m) {
                    const int row = u.pm * BM + ai * HALF + wr * 64 + m * 16 + fr;
                    const f32x4* p = (const f32x4*)(rp + (size_t)row * 16);
                    const f32x4 p0 = p[0], p1 = p[1], p2 = p[2], p3 = p[3];
                    const f32x4 ps = (p0 + p1) + (p2 + p3);
                    const float tot = (ps[0] + ps[1]) + (ps[2] + ps[3]);
                    const float r = rsqrtf(tot * (1.0f / 1024.0f) + 1e-6f);
                    float* yr = y + (size_t)row * D + col0;
#pragma unroll
                    for (int bj = 0; bj < 2; ++bj)
#pragma unroll
                        for (int n = 0; n < 2; ++n) *(f32x4*)(yr + bj * HALF + n * 16) = acc[ai][bj][m][n] * r * fg[bj][n];
                }
        }
        const int srow = (int)blockIdx.x * 8 + wid;
        if (srow < MS) {
            f32x4 v[4]; float ss = 0.f;
#pragma unroll
            for (int q = 0; q < 4; ++q) { v[q] = *(const f32x4*)(xs + (size_t)srow * D + lane * 4 + 256 * q); ss += (v[q][0] * v[q][0] + v[q][1] * v[q][1]) + (v[q][2] * v[q][2] + v[q][3] * v[q][3]); }
            ss = wave_sum(ss);
            const float r = rsqrtf(ss * (1.0f / 1024.0f) + 1e-6f);
#pragma unroll
            for (int q = 0; q < 4; ++q) { const f32x4 fgv = *(const f32x4*)(fgain + lane * 4 + 256 * q); *(f32x4*)(ys + (size_t)srow * D + lane * 4 + 256 * q) = v[q] * r * fgv; }
        }
    }
};

__device__ __forceinline__ void transpose_tile(LAS unsigned char* lds, const float* src, int ldsrc, bf16_t* dst, int ldd, int k0, int n0) {
    LAS float* t = (LAS float*)lds;
    const int tid = threadIdx.x;
    {
        const int k = tid >> 4, n4 = (tid & 15) * 4;
#pragma unroll
        for (int p = 0; p < 2; ++p) {
            const f32x4 v = *(const f32x4*)(src + (size_t)(k0 + k + 32 * p) * ldsrc + n0 + n4);
            LAS float* d = t + (k + 32 * p) * 65 + n4;
            d[0] = v[0]; d[1] = v[1]; d[2] = v[2]; d[3] = v[3];
        }
    }
    __syncthreads();
    {
        const int n = tid >> 3, kc = (tid & 7) * 8;
        const LAS float* s = t + kc * 65 + n;
        u32x4 w;
        w.x = pk_bf16(s[0 * 65], s[1 * 65]); w.y = pk_bf16(s[2 * 65], s[3 * 65]); w.z = pk_bf16(s[4 * 65], s[5 * 65]); w.w = pk_bf16(s[6 * 65], s[7 * 65]);
        *(u32x4*)(dst + (size_t)(n0 + n) * ldd + k0 + kc) = w;
    }
    __syncthreads();
}

__device__ __forceinline__ void p0_phase(const Args& a, LAS unsigned char* lds) {
    const int tid = threadIdx.x;
    unsigned char* ws = a.ws;
    constexpr int N_MOD = 48 * KS_MOD, N_WIN = 16 * 72, N_WAB = 256, N_WO = 256, N_PW = 16, N_SW = 16;
    constexpr int I_WIN = N_MOD, I_WAB = I_WIN + N_WIN, I_WO = I_WAB + N_WAB, I_PW = I_WO + N_WO, I_SW = I_PW + N_PW, I_END = I_SW + N_SW;
    for (int item = blockIdx.x; item < I_END; item += gridDim.x) {
        if (item < N_MOD) {
            const int cb = item % 48, ks = item / 48, n0 = cb * 64, k0 = ks * 128;
            LAS float* s = (LAS float*)lds;
            for (int e = tid; e < NROWC * 128; e += NTHR) {
                const int r = e >> 7, kk = e & 127;
                const float c = r < NB ? a.in[3][r * D + k0 + kk] : a.in[4][(r - NB) * D + k0 + kk];
                s[e] = silu_f(c);
            }
            LAS float* wl = (LAS float*)(lds + 69632);
#pragma unroll
            for (int i = 0; i < 4; ++i) {
                const int idx = tid + NTHR * i, kk = idx >> 4, c4 = (idx & 15) * 4;
                *(LAS f32x4*)(wl + kk * 64 + c4) = *(const f32x4*)(a.in[5] + (size_t)(k0 + kk) * NMOD + n0 + c4);
            }
            __syncthreads();
            const int col = tid & 63, rg = tid >> 6;
            float acc[17];
#pragma unroll
            for (int r = 0; r < 17; ++r) acc[r] = 0.f;
            for (int kk = 0; kk < 128; kk += 4) {
                const float w0 = wl[(kk + 0) * 64 + col], w1 = wl[(kk + 1) * 64 + col], w2 = wl[(kk + 2) * 64 + col], w3 = wl[(kk + 3) * 64 + col];
#pragma unroll
                for (int r = 0; r < 17; ++r) {
                    const f32x4 sv = *(const LAS f32x4*)(s + (rg * 17 + r) * 128 + kk);
                    acc[r] += sv[0] * w0 + sv[1] * w1 + sv[2] * w2 + sv[3] * w3;
                }
            }
            float* mp = (float*)(ws + WS_MODP) + ((size_t)ks * NROWC + rg * 17) * NMOD + n0 + col;
#pragma unroll
            for (int r = 0; r < 17; ++r) mp[(size_t)r * NMOD] = acc[r];
            __syncthreads();
        } else if (item < I_WAB) {
            const int i = item - I_WIN, kt = i & 15, nt = i >> 4;
            int nsrc = nt * 64;
            if (nsrc >= OFF_MA) { const int q = nsrc - OFF_MA, j = q >> 8, wi = q & 255; nsrc = ((wi >> 7) ? OFF_MB : OFF_MA) + j * 128 + (wi & 127); }
            transpose_tile(lds, a.in[8] + nsrc, DIN, (bf16_t*)(ws + WS_WIN) + (size_t)(nt * 64) * D, D, kt * 64, 0);
        } else if (item < I_WO) {
            const int i = item - I_WAB, half = i >> 7, j = i & 127, kt = j & 7, nt = j >> 3;
            transpose_tile(lds, half ? a.in[17] : a.in[16], D, (bf16_t*)(ws + WS_WAB) + half * 512, D, kt * 64, nt * 64);
        } else if (item < I_PW) {
            const int i = item - I_WO, kt = i & 15, nt = i >> 4;
            transpose_tile(lds, a.in[18], D, (bf16_t*)(ws + WS_WO), D, kt * 64, nt * 64);
        } else if (item < I_SW) {
            const int i = item - I_PW, g = i >> 2, kt = i & 1, nt = (i >> 1) & 1;
            transpose_tile(lds, a.in[9] + g * 16384, 128, (bf16_t*)(ws + WS_PW) + g * 16384, 128, kt * 64, nt * 64);
        } else {
            const int i = item - I_SW, idx = i * 4096 + tid * 8, t = (idx >> 7) & 127, s0 = idx & 127;
            const f32x4 v0 = *(const f32x4*)(a.in[14] + idx), v1 = *(const f32x4*)(a.in[14] + idx + 4);
            u32x4 w;
            w.x = pk_bf16(s0 + 0 <= t ? v0[0] : 0.f, s0 + 1 <= t ? v0[1] : 0.f); w.y = pk_bf16(s0 + 2 <= t ? v0[2] : 0.f, s0 + 3 <= t ? v0[3] : 0.f);
            w.z = pk_bf16(s0 + 4 <= t ? v1[0] : 0.f, s0 + 5 <= t ? v1[1] : 0.f); w.w = pk_bf16(s0 + 6 <= t ? v1[2] : 0.f, s0 + 7 <= t ? v1[3] : 0.f);
            *(u32x4*)((bf16_t*)(ws + WS_SW) + idx) = w;
        }
    }
}

__device__ __forceinline__ void h_row(const float* xr, bf16_t* hr, const f32x4 (&s1)[4], const f32x4 (&s0)[4], int lane) {
    f32x4 v[4]; float ss = 0.f;
#pragma unroll
    for (int q = 0; q < 4; ++q) { v[q] = *(const f32x4*)(xr + lane * 4 + 256 * q); ss += (v[q][0] * v[q][0] + v[q][1] * v[q][1]) + (v[q][2] * v[q][2] + v[q][3] * v[q][3]); }
    ss = wave_sum(ss);
    const float r = rsqrtf(ss * (1.0f / 1024.0f) + 1e-6f);
#pragma unroll
    for (int q = 0; q < 4; ++q) {
        const f32x4 h = (v[q] * r) * s1[q] + s0[q];
        u32x2 w; w.x = pk_bf16(h[0], h[1]); w.y = pk_bf16(h[2], h[3]);
        *(u32x2*)(hr + lane * 4 + 256 * q) = w;
    }
}

__device__ __forceinline__ void p1_phase(const Args& a, LAS unsigned char* lds) {
    int tid_ = threadIdx.x; asm volatile("" : "+v"(tid_));
    const int tid = tid_, wid = tid >> 6, lane = tid & 63;
    unsigned char* ws = a.ws;
    const float* modp = (const float*)(ws + WS_MODP);
    const float* b_ada = a.in[6]; const float* ngain = a.in[7];
    bf16_t* hb = (bf16_t*)(ws + WS_HB);
    LAS float* S1 = (LAS float*)lds; LAS float* S0 = S1 + 1024;
    for (int blk = blockIdx.x; blk < 256; blk += gridDim.x) {
        const int b = blk >> 5;
        __syncthreads();
        for (int n = tid; n < D; n += NTHR) {
            float sh = b_ada[n], sc = b_ada[D + n];
#pragma unroll
            for (int ks = 0; ks < KS_MOD; ++ks) { sh += modp[((size_t)ks * NROWC + b) * NMOD + n]; sc += modp[((size_t)ks * NROWC + b) * NMOD + D + n]; }
            S1[n] = (1.0f + sc) * ngain[n]; S0[n] = sh;
        }
        __syncthreads();
        f32x4 s1[4], s0[4];
#pragma unroll
        for (int q = 0; q < 4; ++q) { s1[q] = *(const LAS f32x4*)(S1 + lane * 4 + 256 * q); s0[q] = *(const LAS f32x4*)(S0 + lane * 4 + 256 * q); }
#pragma unroll 2
        for (int j = 0; j < 8; ++j) {
            const int row = blk * 64 + wid * 8 + j;
            h_row(a.in[0] + (size_t)row * D, hb + (size_t)row * D, s1, s0, lane);
        }
    }
    for (int j = (int)blockIdx.x * 8 + wid; j < MS; j += (int)gridDim.x * 8) {
        f32x4 s1[4], s0[4];
#pragma unroll
        for (int q = 0; q < 4; ++q) {
            const int n = lane * 4 + 256 * q;
            f32x4 sh = *(const f32x4*)(b_ada + n), sc = *(const f32x4*)(b_ada + D + n);
#pragma unroll
            for (int ks = 0; ks < KS_MOD; ++ks) {
                sh += *(const f32x4*)(modp + ((size_t)ks * NROWC + NB + j) * NMOD + n);
                sc += *(const f32x4*)(modp + ((size_t)ks * NROWC + NB + j) * NMOD + D + n);
            }
            s1[q] = (sc + 1.0f) * *(const f32x4*)(ngain + n); s0[q] = sh;
        }
        h_row(a.in[1] + (size_t)j * D, hb + (size_t)(MPR + j) * D, s1, s0, lane);
    }
    float* gate = (float*)(ws + WS_GATE);
    for (int r = blockIdx.x; r < NROWC; r += gridDim.x)
        for (int n = tid; n < D; n += NTHR) {
            float g = b_ada[2 * D + n];
#pragma unroll
            for (int ks = 0; ks < KS_MOD; ++ks) g += modp[((size_t)ks * NROWC + r) * NMOD + 2 * D + n];
            gate[(size_t)r * D + n] = g;
        }
}

constexpr int LP = 136;
__device__ __forceinline__ void unpack8(const u32x4 v, f32x4& lo, f32x4& hi) {
    lo = (f32x4){bf_lo(v.x), bf_hi(v.x), bf_lo(v.y), bf_hi(v.y)}; hi = (f32x4){bf_lo(v.z), bf_hi(v.z), bf_lo(v.w), bf_hi(v.w)};
}
__device__ __forceinline__ u32x4 pack8(const f32x4 lo, const f32x4 hi) {
    u32x4 w; w.x = pk_bf16(lo[0], lo[1]); w.y = pk_bf16(lo[2], lo[3]); w.z = pk_bf16(hi[0], hi[1]); w.w = pk_bf16(hi[2], hi[3]); return w;
}

__device__ __forceinline__ void p3_phase(const Args& a, LAS unsigned char* lds) {
    int tid_ = threadIdx.x; asm volatile("" : "+v"(tid_));
    const int tid = tid_, wid = tid >> 6, lane = tid & 63, fr = lane & 15, fq = lane >> 4;
    unsigned char* ws = a.ws;
    const bf16_t* Z = (const bf16_t*)(ws + WS_Z);
    bf16_t* YAB = (bf16_t*)(ws + WS_YAB);
    const bf16_t* PW = (const bf16_t*)(ws + WS_PW);
    const bf16_t* SW = (const bf16_t*)(ws + WS_SW);
    float* out = a.out;
    LAS bf16_t* Xs = (LAS bf16_t*)lds;
    LAS bf16_t* Ys = (LAS bf16_t*)(lds + 34816);
    LAS bf16_t* Es = (LAS bf16_t*)(lds + 69632);
    const int pr = tid >> 4, pc = tid & 15;
    for (int item = blockIdx.x; item < 129 * 8; item += gridDim.x) {
        const int tile = item >> 3, sub = item & 7, g = sub & 3;
        const bool isB = sub >= 4, sample = tile == 128;
        const int row0 = tile * 128, b = tile >> 4, n = tile & 15;
        __syncthreads();
        if (!isB) {
            const int w = 2 << g;
            for (int p = tid; p < 128 * 16; p += NTHR) { const int r = p >> 4, c = p & 15; *(LAS u32x4*)(Xs + r * LP + c * 8) = *(const u32x4*)(PW + g * 16384 + r * 128 + c * 8); }
            if (!sample) {
                for (int p = tid; p < 144 * 16; p += NTHR) {
                    const int r = p >> 4, c = p & 15, t = n * 128 - 16 + r;
                    u32x4 v = (u32x4){0u, 0u, 0u, 0u};
                    if (t >= 0) v = *(const u32x4*)(Z + (size_t)(b * SEQ + t) * DIN + OFF_A + g * 128 + c * 8);
                    *(LAS u32x4*)(Es + r * LP + c * 8) = v;
                }
                __syncthreads();
#pragma unroll 1
                for (int pass = 0; pass < 4; ++pass) {
                    const int t = pass * 32 + pr;
                    f32x4 s_lo = (f32x4){0.f, 0.f, 0.f, 0.f}, s_hi = s_lo, a_lo, a_hi;
                    for (int j = 0; j < w; ++j) {
                        f32x4 lo, hi; unpack8(*(const LAS u32x4*)(Es + (16 + t - j) * LP + pc * 8), lo, hi);
                        s_lo += lo; s_hi += hi;
                        if (j == 0) { a_lo = lo; a_hi = hi; }
                    }
                    const int cnt = min(n * 128 + t + 1, w);
                    const float inv = 1.0f / (float)cnt;
                    *(LAS u32x4*)(Ys + t * LP + pc * 8) = pack8(s_lo * inv - a_lo, s_hi * inv - a_hi);
                    if (n == 15 && t >= 113) {
                        float* o = out + O_PP + ((size_t)(b * 15 + (t - 113)) * 512 + g * 128 + pc * 8);
                        *(f32x4*)o = a_lo; *(f32x4*)(o + 4) = a_hi;
                    }
                }
            } else {
                const float* spool = a.in[2];
#pragma unroll 1
                for (int pass = 0; pass < 4; ++pass) {
                    const int r = pass * 32 + pr;
                    f32x4 a_lo, a_hi; unpack8(*(const u32x4*)(Z + (size_t)(MPR + r) * DIN + OFF_A + g * 128 + pc * 8), a_lo, a_hi);
                    const float* sp = spool + (size_t)r * 15 * 512 + g * 128 + pc * 8;
                    float* o = out + O_PS + (size_t)r * 15 * 512 + g * 128 + pc * 8;
                    f32x4 s_lo = a_lo, s_hi = a_hi;
                    for (int i = 1; i < 15; ++i) {
                        const f32x4 lo = *(const f32x4*)(sp + i * 512), hi = *(const f32x4*)(sp + i * 512 + 4);
                        if (15 - i <= w - 1) { s_lo += lo; s_hi += hi; }
                        *(f32x4*)(o + (i - 1) * 512) = lo; *(f32x4*)(o + (i - 1) * 512 + 4) = hi;
                    }
                    if (w == 16) { s_lo += *(const f32x4*)(sp); s_hi += *(const f32x4*)(sp + 4); }
                    *(f32x4*)(o + 14 * 512) = a_lo; *(f32x4*)(o + 14 * 512 + 4) = a_hi;
                    const float inv = 1.0f / (float)w;
                    *(LAS u32x4*)(Ys + r * LP + pc * 8) = pack8(s_lo * inv - a_lo, s_hi * inv - a_hi);
                }
            }
            __syncthreads();
        } else {
            const float* ln_g = a.in[12]; const float* ln_b = a.in[13];
            if (!sample)
                for (int p = tid; p < 128 * 16; p += NTHR) { const int r = p >> 4, c = p & 15; *(LAS u32x4*)(Ys + r * LP + c * 8) = *(const u32x4*)(SW + g * 16384 + r * 128 + c * 8); }
            const float w00 = a.in[14][g * 16384], sb0 = a.in[15][g * 128];
#pragma unroll 1
            for (int half = 0; half < 2; ++half) {
                u32x4 raw[8];
#pragma unroll
                for (int rr = 0; rr < 8; ++rr) raw[rr] = *(const u32x4*)(Z + (size_t)(row0 + wid * 16 + half * 8 + rr) * DIN + OFF_V + lane * 8);
#pragma unroll
                for (int rr = 0; rr < 8; ++rr) {
                    const int s = wid * 16 + half * 8 + rr;
                    f32x4 lo, hi; unpack8(raw[rr], lo, hi);
                    float sum = (lo[0] + lo[1]) + (lo[2] + lo[3]) + (hi[0] + hi[1]) + (hi[2] + hi[3]);
                    sum = wave_sum(sum);
                    const float mu = sum * (1.0f / 512.0f);
                    lo -= mu; hi -= mu;
                    float q = (lo[0] * lo[0] + lo[1] * lo[1]) + (lo[2] * lo[2] + lo[3] * lo[3]) + (hi[0] * hi[0] + hi[1] * hi[1]) + (hi[2] * hi[2] + hi[3] * hi[3]);
                    q = wave_sum(q);
                    const float rstd = rsqrtf(q * (1.0f / 512.0f) + 1e-6f);
                    if (fq == g) {
                        const int ch = g * 128 + fr * 8;
                        const f32x4 vlo = lo * rstd * *(const f32x4*)(ln_g + ch) + *(const f32x4*)(ln_b + ch);
                        const f32x4 vhi = hi * rstd * *(const f32x4*)(ln_g + ch + 4) + *(const f32x4*)(ln_b + ch + 4);
                        if (!sample) {
                            const u32x4 pk = pack8(vlo, vhi);
                            LAS bf16_t* xp = Xs + (fr * 8) * LP + s;
                            xp[0 * LP] = (bf16_t)(pk.x & 0xffffu); xp[1 * LP] = (bf16_t)(pk.x >> 16); xp[2 * LP] = (bf16_t)(pk.y & 0xffffu); xp[3 * LP] = (bf16_t)(pk.y >> 16);
                            xp[4 * LP] = (bf16_t)(pk.z & 0xffffu); xp[5 * LP] = (bf16_t)(pk.z >> 16); xp[6 * LP] = (bf16_t)(pk.w & 0xffffu); xp[7 * LP] = (bf16_t)(pk.w >> 16);
                            if (n == 15) { float* o = out + O_VP + ((size_t)(b * 128 + s) * 512 + ch); *(f32x4*)o = vlo; *(f32x4*)(o + 4) = vhi; }
                        } else {
                            const size_t row = (size_t)(MPR + s);
                            f32x4 ulo, uhi, glo, ghi;
                            unpack8(*(const u32x4*)(Z + row * DIN + OFF_U + ch), ulo, uhi);
                            unpack8(*(const u32x4*)(Z + row * DIN + OFF_GB + ch), glo, ghi);
                            const f32x4 ylo = ulo * (vlo * w00 + sb0) * glo, yhi = uhi * (vhi * w00 + sb0) * ghi;
                            *(u32x4*)(YAB + row * D + 512 + ch) = pack8(ylo, yhi);
                            float* o = out + O_VS + (size_t)s * 512 + ch; *(f32x4*)o = vlo; *(f32x4*)(o + 4) = vhi;
                        }
                    }
                }
            }
            __syncthreads();
            if (sample) continue;
        }
        f32x4 acc[8];
#pragma unroll
        for (int ct = 0; ct < 8; ++ct) acc[ct] = (f32x4){0.f, 0.f, 0.f, 0.f};
        bf16x8 yf[4];
#pragma unroll
        for (int ks = 0; ks < 4; ++ks) yf[ks] = *(const LAS bf16x8*)(Ys + (wid * 16 + fr) * LP + ks * 32 + fq * 8);
#pragma unroll
        for (int ct = 0; ct < 8; ++ct)
#pragma unroll
            for (int ks = 0; ks < 4; ++ks) {
                const bf16x8 xf = *(const LAS bf16x8*)(Xs + (ct * 16 + fr) * LP + ks * 32 + fq * 8);
                acc[ct] = __builtin_amdgcn_mfma_f32_16x16x32_bf16(xf, yf[ks], acc[ct], 0, 0, 0);
            }
        const int t = wid * 16 + fr;
        const size_t row = (size_t)(row0 + t);
        if (!isB) {
            const float* pool_b = a.in[10]; const float* pool_s = a.in[11];
#pragma unroll
            for (int ct = 0; ct < 8; ++ct) {
                const int ch = g * 128 + ct * 16 + fq * 4;
                const f32x4 pb = *(const f32x4*)(pool_b + ch), ps = *(const f32x4*)(pool_s + ch);
                const u32x2 gv = *(const u32x2*)(Z + row * DIN + OFF_GA + ch);
                const f32x4 ga = (f32x4){bf_lo(gv.x), bf_hi(gv.x), bf_lo(gv.y), bf_hi(gv.y)};
                const f32x4 v = (acc[ct] + pb) * ps * ga;
                u32x2 w; w.x = pk_bf16(v[0], v[1]); w.y = pk_bf16(v[2], v[3]);
                *(u32x2*)(YAB + row * D + ch) = w;
            }
        } else {
            const float sbt = a.in[15][g * 128 + t];
#pragma unroll
            for (int ct = 0; ct < 8; ++ct) {
                const int ch = g * 128 + ct * 16 + fq * 4;
                const u32x2 uv = *(const u32x2*)(Z + row * DIN + OFF_U + ch), gv = *(const u32x2*)(Z + row * DIN + OFF_GB + ch);
                const f32x4 uu = (f32x4){bf_lo(uv.x), bf_hi(uv.x), bf_lo(uv.y), bf_hi(uv.y)}, gb = (f32x4){bf_lo(gv.x), bf_hi(gv.x), bf_lo(gv.y), bf_hi(gv.y)};
                const f32x4 v = uu * (acc[ct] + sbt) * gb;
                u32x2 w; w.x = pk_bf16(v[0], v[1]); w.y = pk_bf16(v[2], v[3]);
                *(u32x2*)(YAB + row * D + 512 + ch) = w;
            }
        }
    }
}

template <int MODE>
__device__ __forceinline__ void sample_gemm(const Args& a, LAS unsigned char* lds) {
    int tid_ = threadIdx.x; asm volatile("" : "+v"(tid_));
    const int tid = tid_, wid = tid >> 6, lane = tid & 63, fr = lane & 15, fq = lane >> 4, rtile = wid & 1, ks = wid >> 1;
    unsigned char* ws = a.ws;
    const bf16_t* A = MODE == 0 ? (const bf16_t*)(ws + WS_YAB) + (size_t)MPR * D : (const bf16_t*)(ws + WS_HB) + (size_t)MPR * D;
    const bf16_t* Wt = MODE == 0 ? (const bf16_t*)(ws + WS_WAB) : (const bf16_t*)(ws + WS_WO);
    LAS f32x4* red = (LAS f32x4*)lds;
    for (int item = blockIdx.x; item < 256; item += gridDim.x) {
        const int rt = item & 3, ct = item >> 2;
        const bf16_t* ap = A + (size_t)(rt * 32 + rtile * 16 + fr) * D + ks * 256 + fq * 8;
        const bf16_t* wp = Wt + (size_t)(ct * 16 + fr) * D + ks * 256 + fq * 8;
        bf16x8 xa[8], xw[8];
#pragma unroll
        for (int s = 0; s < 8; ++s) { xa[s] = *(const bf16x8*)(ap + s * 32); xw[s] = *(const bf16x8*)(wp + s * 32); }
        f32x4 acc = (f32x4){0.f, 0.f, 0.f, 0.f};
#pragma unroll
        for (int s = 0; s < 8; ++s) acc = __builtin_amdgcn_mfma_f32_16x16x32_bf16(xw[s], xa[s], acc, 0, 0, 0);
        __syncthreads();
        red[wid * 64 + lane] = acc;
        __syncthreads();
        if (wid < 2) {
            const f32x4 p0 = red[(0 + wid) * 64 + lane], p1 = red[(2 + wid) * 64 + lane], p2 = red[(4 + wid) * 64 + lane], p3 = red[(6 + wid) * 64 + lane];
            const int row = rt * 32 + wid * 16 + fr, col = ct * 16 + fq * 4;
            if (MODE == 0) {
                const bf16_t* zr = (const bf16_t*)(ws + WS_Z) + (size_t)(MPR + row) * DIN;
                const int zc = OFF_MA + (col >> 7) * 256 + (col & 127);
                const u32x2 sa = *(const u32x2*)(zr + zc), sb = *(const u32x2*)(zr + zc + 128);
                const f32x4 fa = (f32x4){bf_lo(sa.x), bf_hi(sa.x), bf_lo(sa.y), bf_hi(sa.y)}, fb = (f32x4){bf_lo(sb.x), bf_hi(sb.x), bf_lo(sb.y), bf_hi(sb.y)};
                const f32x4 v = fb * (fa * (p0 + p1) + (p2 + p3));
                u32x2 w; w.x = pk_bf16(v[0], v[1]); w.y = pk_bf16(v[2], v[3]);
                *(u32x2*)((bf16_t*)(ws + WS_HB) + (size_t)(MPR + row) * D + col) = w;
            } else {
                const f32x4 xv = *(const f32x4*)(a.in[1] + (size_t)row * D + col);
                const f32x4 gv = *(const f32x4*)((const float*)(ws + WS_GATE) + (size_t)(NB + row) * D + col);
                *(f32x4*)((float*)(ws + WS_XS) + (size_t)row * D + col) = xv + gv * ((p0 + p1) + (p2 + p3));
            }
        }
    }
    __syncthreads();
}

__global__ void __launch_bounds__(NTHR, 2) fwd_kernel(Args a) {
    extern __shared__ __attribute__((aligned(16))) unsigned char lds_raw[];
    LAS unsigned char* lds = (LAS unsigned char*)lds_raw;
    cg::grid_group grid = cg::this_grid();
    unsigned char* ws = a.ws;

    p0_phase(a, lds);
    grid.sync();
    p1_phase(a, lds);
    grid.sync();
    {
        Gemm g{(const bf16_t*)(ws + WS_HB), (const bf16_t*)(ws + WS_WIN), MPAD, DIN, D};
        StaticOrder S; S.init(MPAD, DIN, (int)gridDim.x, (int)blockIdx.x);
        EpiZ E{(bf16_t*)(ws + WS_Z)};
        gemm_phase<EpiZ, StaticOrder>(lds, g, S, E);
    }
    grid.sync();
    p3_phase(a, lds);
    grid.sync();
    {
        sample_gemm<0>(a, lds);
        Gemm g{(const bf16_t*)(ws + WS_YAB), (const bf16_t*)(ws + WS_WAB), MPR, D, D};
        StaticOrder S; S.init(MPR, D, (int)gridDim.x, (int)blockIdx.x);
        EpiMerged E{(const bf16_t*)(ws + WS_Z), (bf16_t*)(ws + WS_HB)};
        gemm_phase<EpiMerged, StaticOrder>(lds, g, S, E);
    }
    grid.sync();
    {
        sample_gemm<1>(a, lds);
        Gemm g{(const bf16_t*)(ws + WS_HB), (const bf16_t*)(ws + WS_WO), MPR, D, D};
        StaticOrder S; S.init(MPR, D, (int)gridDim.x, (int)blockIdx.x);
        EpiFinal E{a.in[0], (const float*)(ws + WS_GATE), a.in[19], (float*)(ws + WS_RP), a.out + O_YP, (const float*)(ws + WS_XS), a.out + O_YS};
        gemm_phase<EpiFinal, StaticOrder>(lds, g, S, E);
    }
}

extern "C" void kernel_launch(void* const* d_in, const int* in_sizes, int n_in, void* d_out, int out_size, void* d_ws, size_t ws_size, hipStream_t stream) {
    static int ready = 0;
    if (ready == 0) {
        ready = -1;
        if (n_in != 20 || in_sizes[0] != MPR * D || ws_size < WS_END) { fprintf(stderr, "kernel_launch: unexpected shapes (n_in %d, ws %zu, need %zu)\n", n_in, ws_size, (size_t)WS_END); return; }
        int dev = 0, cus = 0, per_cu = 0;
        if (hipGetDevice(&dev) != hipSuccess || hipDeviceGetAttribute(&cus, hipDeviceAttributeMultiprocessorCount, dev) != hipSuccess) { fprintf(stderr, "kernel_launch: device query failed\n"); return; }
        if (hipFuncSetAttribute((const void*)fwd_kernel, hipFuncAttributeMaxDynamicSharedMemorySize, LDS_BYTES) != hipSuccess) { fprintf(stderr, "kernel_launch: hipFuncSetAttribute failed\n"); return; }
        if (hipOccupancyMaxActiveBlocksPerMultiprocessor(&per_cu, (const void*)fwd_kernel, NTHR, LDS_BYTES) != hipSuccess) per_cu = 0;
        (void)hipGetLastError();
        if (cus * per_cu < 256) { fprintf(stderr, "kernel_launch: need 256 co-resident workgroups, device offers %d x %d\n", cus, per_cu); return; }
        ready = 1;
    }
    if (ready < 0) return;
    Args a{};
    for (int i = 0; i < 20; ++i) a.in[i] = (const float*)d_in[i];
    a.out = (float*)d_out; a.ws = (unsigned char*)d_ws;
    void* args[] = {&a};
    hipError_t e = hipLaunchCooperativeKernel((const void*)fwd_kernel, dim3(256), dim3(NTHR), args, LDS_BYTES, stream);
    if (e != hipSuccess) fprintf(stderr, "kernel_launch: cooperative launch failed: %s\n", hipGetErrorString(e));
}
```

```cpp
#include <hip/hip_runtime.h>
#include <hip/hip_cooperative_groups.h>
#include <cstdio>
namespace cg = cooperative_groups;

namespace pg8 {
#define PG8_LAS __attribute__((address_space(3)))
typedef unsigned short bf16_t;
typedef short bf16x8 __attribute__((ext_vector_type(8)));
typedef float f32x4 __attribute__((ext_vector_type(4)));
typedef unsigned u32x4 __attribute__((ext_vector_type(4)));
constexpr int BM = 256, BK = 64, HALF = 128, HTB = HALF * BK * 2  , STAGE_BYTES = 8 * HTB, NXCD = 8, WGM = 8;

__host__ __device__ __forceinline__ int lds_byte(int r, int c) { const int st = (r >> 4) * 2 + (c >> 5), rr = r & 15, cc = c & 31, ob = rr * 64 + cc * 2; return st * 1024 + (ob ^ (((ob >> 9) & 1) << 5)); }
__host__ __device__ __forceinline__ void stage_rc(int b, int& R, int& C) { const int st = b / 1024, sb = b % 1024, swz = sb ^ (((sb >> 9) & 1) << 5); R = (st >> 1) * 16 + swz / 64; C = (st & 1) * 32 + (swz % 64) / 2; }
__host__ __device__ __forceinline__ int perm32(int rho) { const int n = rho >> 4, i = rho & 15; return 8 * (i >> 2) + 4 * n + (i & 3); }

struct Unit { int pm, pn, kh = 0; };
struct Gemm { const bf16_t* A; const bf16_t* Bt; int M, N, K, KT; };

struct StaticOrder {
    int nM, nN, nwg, G, c;
    __host__ __device__ void init(int M, int N, int G_, int c_) { nM = M / BM; nN = N / BM; nwg = nM * nN; G = G_; c = c_; }
    __host__ __device__ bool next(int i, Unit& u) const {
        const long L = (long)i * G + c; if (L >= nwg) return false;
        int wgid = (int)L; { const int q = nwg / NXCD, r = nwg % NXCD, xcd = wgid % NXCD, off = wgid / NXCD; wgid = (xcd < r ? xcd * (q + 1) : r * (q + 1) + (xcd - r) * q) + off; }
        const int nig = WGM * nN, gid = wgid / nig, fm = gid * WGM, gsz = (nM - fm) < WGM ? (nM - fm) : WGM;
        u.pm = fm + ((wgid % nig) % gsz); u.pn = (wgid % nig) / gsz; return true;
    }
    __device__ __forceinline__ void a_ready(const Unit&) const {}
    __device__ __forceinline__ void done(const Unit&) const {}
};
__device__ __forceinline__ unsigned cvt_pk_bf16(float lo, float hi) { unsigned r; asm volatile("v_cvt_pk_bf16_f32 %0, %1, %2" : "=v"(r) : "v"(lo), "v"(hi)); return r; }
typedef float f32x2 __attribute__((ext_vector_type(2)));
__device__ __forceinline__ f32x2 gelu_pk(f32x2 v) {
    const f32x2 av = __builtin_elementwise_abs(v), d = av * 0.2316418882f + 1.0f;
    f32x2 t; t.x = __builtin_amdgcn_rcpf(d.x); t.y = __builtin_amdgcn_rcpf(d.y);
    f32x2 q = t * 0.5307027145f + (-0.7265760135f); q = q * t + 0.7107068705f; q = q * t + (-0.142248368f); q = q * t + 0.127414796f; q = q * t;
    const f32x2 s = (v * v) * (-0.72134752044f);
    f32x2 e; e.x = __builtin_amdgcn_exp2f(s.x); e.y = __builtin_amdgcn_exp2f(s.y);
    const f32x2 m = v * (q * e), r = v - m;
    f32x2 o; o.x = v.x < 0.f ? m.x : r.x; o.y = v.y < 0.f ? m.y : r.y; return o;
}

#define PG8_KBODY { \
            const bool last = (t == nt - 2); \
            const char* a1 = cA + (size_t)(t + 1) * kstep; \
            const char* a2 = last ? nA : cA + (size_t)(t + 2) * kstep; const char* b2 = last ? nB : cB + (size_t)(t + 2) * kstep; \
            const char* a3 = a2 + kstep; const char* b3 = b2 + kstep; \
            if (last && has_next) S.a_ready(nxt); \
            PG8_LDB(B0, 0, 0); PG8_SCHED; PG8_LDA(At, 0, 0); PG8_STAGE(PG8_SA(1, 1), a1 + hstep, voffA); \
            PG8_WAIT_L(8); PG8_BAR; PG8_WAIT_L(0); PG8_MMA(0, 0, At, B0); PG8_BAR; PG8_SCHED; \
            PG8_LDB(B1, 0, 1); PG8_STAGE(PG8_SB(0, 0), b2, voffB); \
            PG8_BAR; PG8_WAIT_L(0); PG8_MMA(0, 1, At, B1); PG8_BAR; \
            PG8_LDA(At, 0, 1); PG8_STAGE(PG8_SA(0, 0), a2, voffA); \
            PG8_BAR; PG8_WAIT_L(0); PG8_MMA(1, 0, At, B0); PG8_BAR; PG8_SCHED; \
            PG8_STAGE(PG8_SB(0, 1), b2 + hstep, voffB); \
            PG8_WAIT_V(6); PG8_BAR; PG8_MMA(1, 1, At, B1); PG8_BAR; \
            PG8_LDB(B0, 1, 0); PG8_SCHED; PG8_LDA(At, 1, 0); PG8_STAGE(PG8_SA(0, 1), a2 + hstep, voffA); \
            PG8_WAIT_L(8); PG8_BAR; PG8_WAIT_L(0); PG8_MMA(0, 0, At, B0); PG8_BAR; PG8_SCHED; \
            PG8_LDB(B1, 1, 1); PG8_STAGE(PG8_SB(1, 0), b3, voffB); \
            PG8_BAR; PG8_WAIT_L(0); PG8_MMA(0, 1, At, B1); PG8_BAR; \
            PG8_LDA(At, 1, 1); PG8_STAGE(PG8_SA(1, 0), a3, voffA); \
            PG8_BAR; PG8_WAIT_L(0); PG8_MMA(1, 0, At, B0); PG8_BAR; PG8_SCHED; \
            PG8_STAGE(PG8_SB(1, 1), b3 + hstep, voffB); \
            PG8_WAIT_V(6); PG8_BAR; PG8_MMA(1, 1, At, B1); PG8_BAR; \
        }
template <class Epi, class Sched>
__device__ __forceinline__ void gemm_phase(PG8_LAS unsigned char* lds, const Gemm g, const Sched& S, const Epi& E) {
    int tid_ = threadIdx.x; asm volatile("" : "+v"(tid_));
    const int tid = tid_, wid = __builtin_amdgcn_readfirstlane(tid >> 6), lane = tid & 63, wr = wid >> 2, wc = wid & 3, fr = lane & 15, fq = lane >> 4;
    const int K = g.K, nt = g.KT;
    unsigned voffA[2], voffB[2];
#pragma unroll
    for (int i = 0; i < 2; ++i) { int R, C; stage_rc(tid * 16 + i * 8192, R, C); const int Rb = Epi::PERM ? ((R & ~31) + perm32(R & 31)) : R;
        voffA[i] = (unsigned)(R * K + C) * 2u; voffB[i] = (unsigned)(Rb * K + C) * 2u; }
    const size_t kstep = (size_t)(BK * 2);
    const size_t hstep = (size_t)HALF * K * 2;
    const size_t tstep = 2 * hstep;
    const unsigned ldsw = (unsigned)wid * 1024u;
    const int aoff = lds_byte(wr * 64 + fr, fq * 8), boff = lds_byte(wc * 32 + fr, fq * 8);
#define PG8_SA(b, h) (((b) * 2 + (h)) * HTB)
#define PG8_SB(b, h) ((4 + (b) * 2 + (h)) * HTB)
#define PG8_STAGE(bufoff, gbase, voff) do { _Pragma("unroll") for (int _i = 0; _i < 2; ++_i) \
        __builtin_amdgcn_global_load_lds((const unsigned*)((const char*)(gbase) + (voff)[_i]), (PG8_LAS unsigned*)(lds + (bufoff) + ldsw + _i * 8192), 16, 0, 0); } while (0)
#define PG8_LDA(dst, b, h) do { _Pragma("unroll") for (int m = 0; m < 4; ++m) _Pragma("unroll") for (int k = 0; k < 2; ++k) dst[m][k] = *(const PG8_LAS bf16x8*)(lds + PG8_SA(b, h) + aoff + m * 2048 + k * 1024); } while (0)
#define PG8_LDB(dst, b, h) do { _Pragma("unroll") for (int n = 0; n < 2; ++n) _Pragma("unroll") for (int k = 0; k < 2; ++k) dst[n][k] = *(const PG8_LAS bf16x8*)(lds + PG8_SB(b, h) + boff + n * 2048 + k * 1024); } while (0)
#define PG8_MMA(ai, bj, At, Bt) do { __builtin_amdgcn_s_setprio(1); _Pragma("unroll") for (int m = 0; m < 4; ++m) _Pragma("unroll") for (int n = 0; n < 2; ++n) _Pragma("unroll") for (int k = 0; k < 2; ++k) \
        acc[ai][bj][m][n] = __builtin_amdgcn_mfma_f32_16x16x32_bf16(Bt[n][k], At[m][k], acc[ai][bj][m][n], 0, 0, 0); __builtin_amdgcn_s_setprio(0); } while (0)
#define PG8_WAIT_V(n) asm volatile("s_waitcnt vmcnt(" #n ")" ::: "memory")
#define PG8_WAIT_L(n) asm volatile("s_waitcnt lgkmcnt(" #n ")" ::: "memory")
#define PG8_BAR __builtin_amdgcn_s_barrier()
#define PG8_SCHED __builtin_amdgcn_sched_barrier(0)
    Unit cur, nxt; int ui = 0;
    if (!S.next(0, cur)) return;
    f32x4 acc[2][2][4][2];
#pragma unroll
    for (int a = 0; a < 2; ++a)
#pragma unroll
        for (int b = 0; b < 2; ++b)
#pragma unroll
            for (int m = 0; m < 4; ++m)
#pragma unroll
                for (int n = 0; n < 2; ++n) acc[a][b][m][n] = (f32x4){0.f, 0.f, 0.f, 0.f};
    bf16x8 At[4][2], B0[2][2], B1[2][2];
    const char* cA = (const char*)g.A + (size_t)cur.pm * tstep + cur.kh; const char* cB = (const char*)g.Bt + (size_t)cur.pn * tstep + cur.kh;
    S.a_ready(cur);
    PG8_STAGE(PG8_SB(0, 0), cB, voffB); PG8_STAGE(PG8_SA(0, 0), cA, voffA); PG8_STAGE(PG8_SB(0, 1), cB + hstep, voffB); PG8_STAGE(PG8_SA(0, 1), cA + hstep, voffA);
    if (wr == 1) PG8_BAR;
    PG8_WAIT_V(4); PG8_BAR;
    PG8_STAGE(PG8_SB(1, 0), cB + kstep, voffB); PG8_STAGE(PG8_SA(1, 0), cA + kstep, voffA); PG8_STAGE(PG8_SB(1, 1), cB + hstep + kstep, voffB);
    PG8_WAIT_V(6); PG8_BAR;
    for (;;) {
        const bool has_next = S.next(ui + 1, nxt);
        const char* nA = has_next ? (const char*)g.A + (size_t)nxt.pm * tstep + nxt.kh : cA; const char* nB = has_next ? (const char*)g.Bt + (size_t)nxt.pn * tstep + nxt.kh : cB;
        if constexpr (Epi::MIDK) {
            for (int t = 0; t < (nt >> 1); t += 2) PG8_KBODY
            E.mid(acc, cur, wr, wc, fr, fq);
            for (int t = (nt >> 1); t < nt; t += 2) PG8_KBODY
        } else {
            for (int t = 0; t < nt; t += 2) PG8_KBODY
        }
        if constexpr (!Epi::AFTER_DRAIN) { E(acc, cur, wr, wc, fr, fq); S.done(cur); }
        if (!has_next) break;
        if (!(Epi::KEEP && E.keep(cur))) {
#pragma unroll
        for (int a = 0; a < 2; ++a)
#pragma unroll
            for (int b = 0; b < 2; ++b)
#pragma unroll
                for (int m = 0; m < 4; ++m)
#pragma unroll
                    for (int n = 0; n < 2; ++n) acc[a][b][m][n] = (f32x4){0.f, 0.f, 0.f, 0.f};
        }
        cur = nxt; cA = nA; cB = nB; ++ui;
    }
    PG8_WAIT_V(0);
    if (wr == 0) PG8_BAR;
    PG8_BAR;
    if constexpr (Epi::AFTER_DRAIN) { E.fused(acc, cur, wr, wc, fr, fq, lds, wid, lane); S.done(cur); }
#undef PG8_KBODY
#undef PG8_SA
#undef PG8_SB
#undef PG8_STAGE
#undef PG8_LDA
#undef PG8_LDB
#undef PG8_MMA
#undef PG8_WAIT_V
#undef PG8_WAIT_L
#undef PG8_BAR
#undef PG8_SCHED
}
}
#define LAS PG8_LAS
#define XB_TMO      128
#define XB_XCNT(j)  (256  + 64 * (j))
#define XB_XSUB(j)  (1280 + 64 * (j))
#define XB_XGEN(j)  (2304 + 64 * (j))
#define XB_TOP      3328
#define XB_TOPGEN   3392
#define XCD_BAR_WORDS 3456
#define XB_SPIN_CAP (1u << 18)

__device__ __forceinline__ unsigned xb_ld(unsigned* p)              { return __hip_atomic_load(p, __ATOMIC_RELAXED, __HIP_MEMORY_SCOPE_AGENT); }
__device__ __forceinline__ unsigned xb_add(unsigned* p, unsigned v) { return __hip_atomic_fetch_add(p, v, __ATOMIC_RELAXED, __HIP_MEMORY_SCOPE_AGENT); }
__device__ __forceinline__ unsigned xb_xcc_id() { return (unsigned)__builtin_amdgcn_s_getreg((3 << 11) | 20) & 0xFu; }
#define XB_SPIN(cond, bar) do { unsigned _sp = 0; while (cond) { __builtin_amdgcn_s_sleep(1); \
    if ((++_sp & 255u) == 0u) { if (xb_ld(&(bar)[XB_TMO])) break; if (_sp > XB_SPIN_CAP) { atomicAdd(&(bar)[XB_TMO], 1u); break; } } } } while (0)

struct XcdBarrier {
    unsigned* bar; unsigned x;
    volatile LAS unsigned* st;
};

__device__ __forceinline__ XcdBarrier xcd_barrier_post(unsigned* bar, volatile LAS unsigned* st) {
    XcdBarrier b; b.bar = bar; b.x = xb_xcc_id(); b.st = st;
    if (threadIdx.x == 0) (void)xb_add(&bar[XB_XCNT(b.x)], 1u);
    return b;
}
__device__ __forceinline__ void xcd_barrier_complete(unsigned* bar, unsigned x, unsigned& nloc, unsigned& nx) {
    const unsigned G = gridDim.x * gridDim.y * gridDim.z;
    unsigned sum, cnt, mine, sp = 0u;
    for (;;) {
        sum = 0u; cnt = 0u; mine = 0u;
#pragma unroll
        for (unsigned j = 0; j < 16; ++j) { const unsigned c = xb_ld(&bar[XB_XCNT(j)]); sum += c; cnt += (c > 0u) ? 1u : 0u; mine = (j == x) ? c : mine; }
        if (sum == G) break;
        __builtin_amdgcn_s_sleep(1);
        if ((++sp & 255u) == 0u) { if (xb_ld(&bar[XB_TMO])) break; if (sp > XB_SPIN_CAP) { atomicAdd(&bar[XB_TMO], 1u); break; } }
    }
    nloc = mine > 0u ? mine : 1u; nx = cnt > 0u ? cnt : 1u;
}

__device__ __forceinline__ void xcd_barrier(const XcdBarrier& b) {
    asm volatile("s_waitcnt vmcnt(0)" ::: "memory");
    __syncthreads();
    if (threadIdx.x == 0) {
        unsigned* bar = b.bar;
        __builtin_amdgcn_s_waitcnt(0);
        unsigned nloc = b.st[0], nx = b.st[1];
        if (nloc == 0u) { xcd_barrier_complete(bar, b.x, nloc, nx); b.st[0] = nloc; b.st[1] = nx; }
        const unsigned old = xb_add(&bar[XB_XSUB(b.x)], 1u);
        const unsigned gen = old / nloc;
        if (old + 1u == (gen + 1u) * nloc) {
            __builtin_amdgcn_fence(__ATOMIC_RELEASE, "agent");
            asm volatile("s_waitcnt vmcnt(0)" ::: "memory");
            const unsigned og = xb_add(&bar[XB_TOP], 1u);
            const unsigned tg = og / nx;
            if (og + 1u == (tg + 1u) * nx) xb_add(&bar[XB_TOPGEN], 1u);
            else XB_SPIN(xb_ld(&bar[XB_TOPGEN]) == tg, bar);
            __builtin_amdgcn_fence(__ATOMIC_ACQUIRE, "agent");
            xb_add(&bar[XB_XGEN(b.x)], 1u);
            asm volatile("s_waitcnt vmcnt(0)" ::: "memory");
        } else {
            XB_SPIN(xb_ld(&bar[XB_XGEN(b.x)]) == gen, bar);
            __builtin_amdgcn_fence(__ATOMIC_ACQUIRE, "agent");
            asm volatile("s_waitcnt vmcnt(0)" ::: "memory");
        }
    }
    __syncthreads();
}

using namespace pg8;
#define BID ((int)__builtin_amdgcn_readfirstlane((int)blockIdx.x))
#define LAS PG8_LAS
typedef unsigned u32x2 __attribute__((ext_vector_type(2)));

constexpr int D = 1024, NB = 8, SEQ = 2048, MPR = NB * SEQ, MS = 128, MT = MPR + MS, MPAD = 16640;
constexpr int DIN = 4608, NMOD = 3072, NROWC = 136, KS_MOD = 8;
constexpr int NCG = 36, ZBLK = 16384;
constexpr int OFF_A = 0, OFF_GA = 512, OFF_U = 1024, OFF_V = 1536, OFF_GB = 2048, OFF_MA = 2560, OFF_MB = 3584;
constexpr size_t O_YP = 0, O_YS = 16777216, O_PP = 16908288, O_PS = 16969728, O_VP = 17952768, O_VS = 18477056;
constexpr size_t WS_MODP = 0;
constexpr size_t WS_GATE = WS_MODP + 13369344;
constexpr size_t WS_HB = WS_GATE + 557056;
constexpr size_t WS_WIN = WS_HB + 34078720;
constexpr size_t WS_WAB = WS_WIN + 9437184;
constexpr size_t WS_WO = WS_WAB + 2097152;
constexpr size_t WS_PW = WS_WO + 2097152;
constexpr size_t WS_SW = WS_PW + 131072;
constexpr size_t WS_Z = WS_SW + 131072;
constexpr size_t WS_YAB = WS_Z + 153354240;
constexpr size_t WS_RP = WS_YAB + 34078720;
constexpr size_t WS_XS = WS_RP + 1048576;
constexpr size_t WS_STATS = WS_XS + 524288;
constexpr size_t WS_PRESUM = WS_STATS + 133120;
constexpr size_t WS_BAR = WS_PRESUM + 262144;
constexpr size_t WS_END = WS_BAR + 16384;
constexpr int LDS_BAR_OFF = 131072, LDS_BYTES = 131072 + 64;
constexpr int NTHR = 512;

struct Args { const float* in[20]; float* out; unsigned char* ws; };

__device__ __forceinline__ unsigned pk_bf16(float lo, float hi) { unsigned r; asm("v_cvt_pk_bf16_f32 %0, %1, %2" : "=v"(r) : "v"(lo), "v"(hi)); return r; }
__device__ __forceinline__ float bf_lo(unsigned u) { return __uint_as_float(u << 16); }
__device__ __forceinline__ float bf_hi(unsigned u) { return __uint_as_float(u & 0xffff0000u); }
__device__ __forceinline__ float sigmoid_f(float x) { return __builtin_amdgcn_rcpf(1.0f + __expf(-x)); }
__device__ __forceinline__ float silu_f(float x) { return x * sigmoid_f(x); }
__device__ __forceinline__ float wave_sum(float v) {
    v += __shfl_xor(v, 1); v += __shfl_xor(v, 2); v += __shfl_xor(v, 4); v += __shfl_xor(v, 8); v += __shfl_xor(v, 16); v += __shfl_xor(v, 32); return v;
}
__device__ __forceinline__ f32x4 act4(f32x4 v, int act) {
    if (act == 1) { v[0] = silu_f(v[0]); v[1] = silu_f(v[1]); v[2] = silu_f(v[2]); v[3] = silu_f(v[3]); }
    else if (act == 2) { const f32x2 a = gelu_pk((f32x2){v[0], v[1]}), b = gelu_pk((f32x2){v[2], v[3]}); v = (f32x4){a.x, a.y, b.x, b.y}; }
    else if (act == 3) { v[0] = sigmoid_f(v[0]); v[1] = sigmoid_f(v[1]); v[2] = sigmoid_f(v[2]); v[3] = sigmoid_f(v[3]); }
    return v;
}

struct EpiZ {
    static constexpr bool PERM = true, AFTER_DRAIN = false, MIDK = false, KEEP = false;
    __device__ __forceinline__ bool keep(const Unit&) const { return false; }
    bf16_t* Z; float* stats;
    __device__ __forceinline__ void mid(f32x4 (&)[2][2][4][2], const Unit&, int, int, int, int) const {}
    __device__ __forceinline__ void fused(f32x4 (&)[2][2][4][2], const Unit&, int, int, int, int, LAS unsigned char*, int, int) const {}
    __device__ __forceinline__ void operator()(const f32x4 (&acc)[2][2][4][2], const Unit& u, int wr, int wc, int fr, int fq) const {
        int t_ = threadIdx.x; asm volatile("" : "+v"(t_));
        { const int wid_ = __builtin_amdgcn_readfirstlane(t_ >> 6), lane_ = t_ & 63; wr = wid_ >> 2; wc = wid_ & 3; fr = lane_ & 15; fq = lane_ >> 4; }
        const int pn = u.pn;
        const int act = pn < 2 ? 0 : pn < 4 ? 1 : pn < 8 ? 4 : pn < 10 ? 2 : 3;
        const bool isv = (pn == 8) || (pn == 9);
        const int cg0 = (pn >= 4 && pn < 8) ? 4 + pn : (pn == 8 || pn == 9) ? pn + 4 + (pn - 8) : pn * 2;
#pragma unroll
        for (int ai = 0; ai < 2; ++ai) {
            const int rt = u.pm * 2 + ai;
            if (rt * 128 < MT) {
                bf16_t* blk = Z + ((size_t)rt * NCG + cg0) * ZBLK + wc * 32 + 8 * fq;
#pragma unroll
                for (int m = 0; m < 4; ++m) {
                    const int r = wr * 64 + m * 16 + fr;
                    bf16_t* rowp = blk + r * 128;
                    if (act == 3) {
                        f32x4 rr[2], sb[2];
#pragma unroll
                        for (int n = 0; n < 2; ++n)
#pragma unroll
                            for (int j = 0; j < 4; ++j) { const float eb = 1.0f + fminf(__expf(-acc[ai][1][m][n][j]), 1e6f), ea = 1.0f + __expf(-acc[ai][0][m][n][j]); sb[n][j] = __builtin_amdgcn_rcpf(eb); rr[n][j] = eb * __builtin_amdgcn_rcpf(ea); }
                        u32x4 w; w.x = pk_bf16(rr[0][0], rr[0][1]); w.y = pk_bf16(rr[0][2], rr[0][3]); w.z = pk_bf16(rr[1][0], rr[1][1]); w.w = pk_bf16(rr[1][2], rr[1][3]);
                        *(u32x4*)(rowp) = w;
                        w.x = pk_bf16(sb[0][0], sb[0][1]); w.y = pk_bf16(sb[0][2], sb[0][3]); w.z = pk_bf16(sb[1][0], sb[1][1]); w.w = pk_bf16(sb[1][2], sb[1][3]);
                        *(u32x4*)(rowp + ZBLK) = w;
                    } else if (act == 4) {
                        const f32x4 u0 = act4(acc[ai][0][m][0], 2), u1 = act4(acc[ai][0][m][1], 2), g0 = act4(acc[ai][1][m][0], 1), g1 = act4(acc[ai][1][m][1], 1);
                        const f32x4 p0 = u0 * g0, p1 = u1 * g1;
                        u32x4 w; w.x = pk_bf16(p0[0], p0[1]); w.y = pk_bf16(p0[2], p0[3]); w.z = pk_bf16(p1[0], p1[1]); w.w = pk_bf16(p1[2], p1[3]);
                        *(u32x4*)(rowp) = w;
                    } else {
                        float ssum = 0.f, ssq = 0.f;
#pragma unroll
                        for (int bj = 0; bj < 2; ++bj) {
                            const f32x4 v0 = act4(acc[ai][bj][m][0], act), v1 = act4(acc[ai][bj][m][1], act);
                            u32x4 w; w.x = pk_bf16(v0[0], v0[1]); w.y = pk_bf16(v0[2], v0[3]); w.z = pk_bf16(v1[0], v1[1]); w.w = pk_bf16(v1[2], v1[3]);
                            *(u32x4*)(rowp + bj * ZBLK) = w;
                            if (isv) {
                                ssum += (v0[0] + v0[1]) + (v0[2] + v0[3]) + (v1[0] + v1[1]) + (v1[2] + v1[3]);
                                ssq += (v0[0] * v0[0] + v0[1] * v0[1]) + (v0[2] * v0[2] + v0[3] * v0[3]) + (v1[0] * v1[0] + v1[1] * v1[1]) + (v1[2] * v1[2] + v1[3] * v1[3]);
                            }
                        }
                        if (isv) {
                            ssum += __shfl_xor(ssum, 16); ssum += __shfl_xor(ssum, 32); ssq += __shfl_xor(ssq, 16); ssq += __shfl_xor(ssq, 32);
                            if (fq == 0) {
                                float* sp = stats + (size_t)(rt * 128 + r) * 2;
                                __hip_atomic_fetch_add(sp, ssum, __ATOMIC_RELAXED, __HIP_MEMORY_SCOPE_AGENT);
                                __hip_atomic_fetch_add(sp + 1, ssq, __ATOMIC_RELAXED, __HIP_MEMORY_SCOPE_AGENT);
                            }
                        }
                    }
                }
            }
        }
    }
};

struct EpiMerged {
    static constexpr bool PERM = true, AFTER_DRAIN = false, MIDK = false, KEEP = true;
    const bf16_t* Z; bf16_t* O;
    __device__ __forceinline__ bool keep(const Unit& u) const { return u.kh == 0; }
    __device__ __forceinline__ void mid(f32x4 (&)[2][2][4][2], const Unit&, int, int, int, int) const {}
    __device__ __forceinline__ void fused(f32x4 (&)[2][2][4][2], const Unit&, int, int, int, int, LAS unsigned char*, int, int) const {}
    __device__ __forceinline__ void operator()(f32x4 (&acc)[2][2][4][2], const Unit& u, int wr, int wc, int fr, int fq) const {
        const char* zb = (const char*)Z;
        const bool first = u.kh == 0;
        const unsigned off0 = (((unsigned)(u.pm * 2) * NCG + (first ? 20 : 21) + 4 * u.pn) * ZBLK + (wr * 64 + fr) * 128 + wc * 32 + 8 * fq) * 2u;
        const int row0 = u.pm * BM + wr * 64 + fr, col0 = u.pn * BM + wc * 32 + 8 * fq;
#pragma unroll
        for (int ai = 0; ai < 2; ++ai) {
            u32x4 r[4][2];
#pragma unroll
            for (int m = 0; m < 4; ++m)
#pragma unroll
                for (int bj = 0; bj < 2; ++bj) r[m][bj] = *(const u32x4*)(zb + off0 + (unsigned)((ai * NCG + 2 * bj) * ZBLK + m * 16 * 128) * 2u);
#pragma unroll
            for (int m = 0; m < 4; ++m)
#pragma unroll
                for (int bj = 0; bj < 2; ++bj) {
                    const u32x4 a = r[m][bj];
                    const f32x4 v0 = acc[ai][bj][m][0] * (f32x4){bf_lo(a.x), bf_hi(a.x), bf_lo(a.y), bf_hi(a.y)};
                    const f32x4 v1 = acc[ai][bj][m][1] * (f32x4){bf_lo(a.z), bf_hi(a.z), bf_lo(a.w), bf_hi(a.w)};
                    if (first) { acc[ai][bj][m][0] = v0; acc[ai][bj][m][1] = v1; }
                    else {
                        u32x4 w; w.x = pk_bf16(v0[0], v0[1]); w.y = pk_bf16(v0[2], v0[3]); w.z = pk_bf16(v1[0], v1[1]); w.w = pk_bf16(v1[2], v1[3]);
                        *(u32x4*)(O + (size_t)(row0 + ai * HALF + m * 16) * D + col0 + bj * HALF) = w;
                    }
                }
            asm volatile("" ::: "memory");
        }
    }
};

struct EpiFinal {
    static constexpr bool PERM = false, AFTER_DRAIN = true, MIDK = false, KEEP = false;
    __device__ __forceinline__ bool keep(const Unit&) const { return false; }
    const float* x; const float* gate; const float* fgain; float* rp; float* y; const float* xs; float* ys; unsigned* barw;
    __device__ __forceinline__ void mid(f32x4 (&)[2][2][4][2], const Unit&, int, int, int, int) const {}
    __device__ __forceinline__ void operator()(const f32x4 (&)[2][2][4][2], const Unit&, int, int, int, int) const {}
    __device__ __forceinline__ void fused(f32x4 (&acc)[2][2][4][2], const Unit& u, int wr, int wc, int fr, int fq, LAS unsigned char* lds, int wid, int lane) const {
        int t_ = threadIdx.x; asm volatile("" : "+v"(t_));
        { const int wid_ = __builtin_amdgcn_readfirstlane(t_ >> 6), lane_ = t_ & 63; wr = wid_ >> 2; wc = wid_ & 3; fr = lane_ & 15; fq = lane_ >> 4; }
        wid = t_ >> 6; lane = t_ & 63;
        const int col0 = u.pn * BM + wc * 32 + 4 * fq, b = u.pm >> 3;
        {
            f32x4 g[2][2];
#pragma unroll
            for (int bj = 0; bj < 2; ++bj)
#pragma unroll
                for (int n = 0; n < 2; ++n) g[bj][n] = *(const f32x4*)(gate + b * D + col0 + bj * HALF + n * 16);
#pragma unroll
            for (int ai = 0; ai < 2; ++ai)
#pragma unroll
                for (int m = 0; m < 4; ++m) {
                    const int row = u.pm * BM + ai * HALF + wr * 64 + m * 16 + fr;
                    const float* xr = x + (size_t)row * D + col0;
                    float ss = 0.f;
#pragma unroll
                    for (int bj = 0; bj < 2; ++bj)
#pragma unroll
                        for (int n = 0; n < 2; ++n) {
                            const f32x4 xv = *(const f32x4*)(xr + bj * HALF + n * 16);
                            const f32x4 v = xv + g[bj][n] * acc[ai][bj][m][n];
                            acc[ai][bj][m][n] = v;
                            ss += (v[0] * v[0] + v[1] * v[1]) + (v[2] * v[2] + v[3] * v[3]);
                        }
                    ss += __shfl_xor(ss, 16); ss += __shfl_xor(ss, 32);
                    if (fq == 0) rp[(size_t)row * 16 + u.pn * 4 + wc] = ss;
                    if (m == 3) asm volatile("" ::: "memory");
                }
        }
        { XcdBarrier b_; b_.bar = barw; b_.x = xb_xcc_id(); b_.st = (volatile LAS unsigned*)(lds + LDS_BAR_OFF); xcd_barrier(b_); }
        {
            f32x4 fg[2][2];
#pragma unroll
            for (int bj = 0; bj < 2; ++bj)
#pragma unroll
                for (int n = 0; n < 2; ++n) fg[bj][n] = *(const f32x4*)(fgain + col0 + bj * HALF + n * 16);
#pragma unroll
            for (int ai = 0; ai < 2; ++ai)
#pragma unroll
                for (int m = 0; m < 4; ++m) {
                    const int row = u.pm * BM + ai * HALF + wr * 64 + m * 16 + fr;
                    const f32x4* p = (const f32x4*)(rp + (size_t)row * 16);
                    const f32x4 p0 = p[0], p1 = p[1], p2 = p[2], p3 = p[3];
                    const f32x4 ps = (p0 + p1) + (p2 + p3);
                    const float tot = (ps[0] + ps[1]) + (ps[2] + ps[3]);
                    const float r = rsqrtf(tot * (1.0f / 1024.0f) + 1e-6f);
                    float* yr = y + (size_t)row * D + col0;
#pragma unroll
                    for (int bj = 0; bj < 2; ++bj)
#pragma unroll
                        for (int n = 0; n < 2; ++n) *(f32x4*)(yr + bj * HALF + n * 16) = acc[ai][bj][m][n] * r * fg[bj][n];
                }
        }
        const int srow = BID * 8 + wid;
        if (srow < MS) {
            f32x4 v[4]; float ss = 0.f;
#pragma unroll
            for (int q = 0; q < 4; ++q) { v[q] = *(const f32x4*)(xs + (size_t)srow * D + lane * 4 + 256 * q); ss += (v[q][0] * v[q][0] + v[q][1] * v[q][1]) + (v[q][2] * v[q][2] + v[q][3] * v[q][3]); }
            ss = wave_sum(ss);
            const float r = rsqrtf(ss * (1.0f / 1024.0f) + 1e-6f);
#pragma unroll
            for (int q = 0; q < 4; ++q) { const f32x4 fgv = *(const f32x4*)(fgain + lane * 4 + 256 * q); *(f32x4*)(ys + (size_t)srow * D + lane * 4 + 256 * q) = v[q] * r * fgv; }
        }
    }
};

constexpr int N_ORDER_B = 146;
struct OrderAB {
    int c, stage;
    __device__ __forceinline__ bool next(int i, Unit& u) const {
        if (stage == 0) {
            if (i >= 4) return false;
            const int j = i * 32 + (c >> 3); int pm = 8 * (c & 7) + (j & 7), pn = j >> 3;
            if (pn == 15 && pm < 10) { pn = pm; pm = 64; }
            u.pm = pm; u.pn = pn; return true;
        }
        if (i > 0 || c >= N_ORDER_B) return false;
        if (c < 128) { u.pm = c >> 1; u.pn = 16 + (c & 1); } else if (c < 136) { u.pm = 64; u.pn = 10 + (c - 128); } else { u.pm = c - 136; u.pn = 15; }
        return true;
    }
    __device__ __forceinline__ void a_ready(const Unit&) const {}
    __device__ __forceinline__ void done(const Unit&) const {}
};

struct OrderK2 {
    StaticOrder so;
    __device__ __forceinline__ bool next(int i, Unit& u) const { if (i >= 2) return false; if (!so.next(0, u)) return false; u.kh = i * 1024; return true; }
    __device__ __forceinline__ void a_ready(const Unit&) const {}
    __device__ __forceinline__ void done(const Unit&) const {}
};

__device__ __forceinline__ void transpose_tile(LAS unsigned char* lds, const float* src, int ldsrc, bf16_t* dst, int ldd, int k0, int n0) {
    LAS float* t = (LAS float*)lds;
    const int tid = threadIdx.x;
    {
        f32x4 v[4];
#pragma unroll
        for (int i = 0; i < 4; ++i) { const int idx = tid + NTHR * i, k = idx >> 4, n4 = (idx & 15) * 4; v[i] = *(const f32x4*)(src + (size_t)(k0 + k) * ldsrc + n0 + n4); }
#pragma unroll
        for (int i = 0; i < 4; ++i) { const int idx = tid + NTHR * i, k = idx >> 4, n4 = (idx & 15) * 4; LAS float* d = t + k * 65 + n4; d[0] = v[i][0]; d[1] = v[i][1]; d[2] = v[i][2]; d[3] = v[i][3]; }
    }
    __syncthreads();
#pragma unroll
    for (int i = 0; i < 2; ++i) {
        const int idx = tid + NTHR * i, n = idx >> 4, kc = (idx & 15) * 8;
        const LAS float* s = t + kc * 65 + n;
        u32x4 w;
        w.x = pk_bf16(s[0 * 65], s[1 * 65]); w.y = pk_bf16(s[2 * 65], s[3 * 65]); w.z = pk_bf16(s[4 * 65], s[5 * 65]); w.w = pk_bf16(s[6 * 65], s[7 * 65]);
        *(u32x4*)(dst + (size_t)(n0 + n) * ldd + k0 + kc) = w;
    }
    __syncthreads();
}

__device__ __forceinline__ void p0_phase(const Args& a, LAS unsigned char* lds) {
    int tid_ = threadIdx.x; asm volatile("" : "+v"(tid_));
    const int tid = tid_, wid = tid >> 6, lane = tid & 63, fr = lane & 15, fq = lane >> 4;
    unsigned char* ws = a.ws;
    for (int i = tid; i < 130; i += NTHR) ((float*)(ws + WS_STATS))[BID * 130 + i] = 0.f;
    if (tid < 64) {
        const int task = BID * 64 + tid, r = task >> 7, c4 = (task & 127) * 4, w = 2 << (c4 >> 7);
        const float* sp = a.in[2] + (size_t)r * 15 * 512 + c4;
        float* o = a.out + O_PS + (size_t)r * 15 * 512 + c4;
        f32x4 pv[15];
#pragma unroll
        for (int i = 0; i < 15; ++i) pv[i] = *(const f32x4*)(sp + i * 512);
        f32x4 ps = (f32x4){0.f, 0.f, 0.f, 0.f};
#pragma unroll
        for (int i = 0; i < 15; ++i) { if (15 - i <= w - 1) ps += pv[i]; if (i >= 1) *(f32x4*)(o + (i - 1) * 512) = pv[i]; }
        *(f32x4*)((float*)(ws + WS_PRESUM) + (size_t)r * 512 + c4) = ps;
    }
    constexpr int N_MOD = 24 * KS_MOD, N_WIN = 8 * 72, N_WAB = 128, N_WO = 128, N_PW = 8, N_SW = 16;
    constexpr int I_WIN = N_MOD, I_WAB = I_WIN + N_WIN, I_WO = I_WAB + N_WAB, I_PW = I_WO + N_WO, I_SW = I_PW + N_PW, I_END = I_SW + N_SW;
    for (int item = BID; item < I_END; item += gridDim.x) {
        if (item < N_MOD) {
            const int ks = item / 24, ng = item % 24, k0 = ks * 128, n0 = ng * 128 + wid * 16;
            LAS bf16_t* As = (LAS bf16_t*)lds;
            float bw[4][8];
#pragma unroll
            for (int q = 0; q < 4; ++q)
#pragma unroll
                for (int j = 0; j < 8; ++j) bw[q][j] = a.in[5][(size_t)(k0 + q * 32 + fq * 8 + j) * NMOD + n0 + fr];
            {
                f32x4 clo[5], chi[5];
#pragma unroll
                for (int i = 0; i < 5; ++i) {
                    const int p = tid + NTHR * i, r = p >> 4, c8 = (p & 15) * 8;
                    clo[i] = (f32x4){0.f, 0.f, 0.f, 0.f}; chi[i] = clo[i];
                    if (r < NROWC) { const float* cp = (r < NB ? a.in[3] + r * D : a.in[4] + (r - NB) * D) + k0 + c8; clo[i] = *(const f32x4*)cp; chi[i] = *(const f32x4*)(cp + 4); }
                }
#pragma unroll
                for (int i = 0; i < 5; ++i) {
                    const int p = tid + NTHR * i, r = p >> 4, c8 = (p & 15) * 8;
                    if (p < 144 * 16) {
                        u32x4 w = (u32x4){0u, 0u, 0u, 0u};
                        if (r < NROWC) { const f32x4 lo = clo[i], hi = chi[i];
                            w.x = pk_bf16(silu_f(lo[0]), silu_f(lo[1])); w.y = pk_bf16(silu_f(lo[2]), silu_f(lo[3])); w.z = pk_bf16(silu_f(hi[0]), silu_f(hi[1])); w.w = pk_bf16(silu_f(hi[2]), silu_f(hi[3])); }
                        *(LAS u32x4*)(As + r * 136 + c8) = w;
                    }
                }
            }
            __syncthreads();
            bf16x8 bfr[4];
#pragma unroll
            for (int q = 0; q < 4; ++q) {
                u32x4 w; w.x = pk_bf16(bw[q][0], bw[q][1]); w.y = pk_bf16(bw[q][2], bw[q][3]); w.z = pk_bf16(bw[q][4], bw[q][5]); w.w = pk_bf16(bw[q][6], bw[q][7]);
                bfr[q] = __builtin_bit_cast(bf16x8, w);
            }
            float* mp = (float*)(ws + WS_MODP) + (size_t)ks * NROWC * NMOD + n0 + fr;
#pragma unroll
            for (int rt = 0; rt < 9; ++rt) {
                f32x4 acc = (f32x4){0.f, 0.f, 0.f, 0.f};
#pragma unroll
                for (int q = 0; q < 4; ++q) {
                    const bf16x8 af = *(const LAS bf16x8*)(As + (rt * 16 + fr) * 136 + q * 32 + fq * 8);
                    acc = __builtin_amdgcn_mfma_f32_16x16x32_bf16(af, bfr[q], acc, 0, 0, 0);
                }
#pragma unroll
                for (int r = 0; r < 4; ++r) { const int row = rt * 16 + fq * 4 + r; if (row < NROWC) mp[(size_t)row * NMOD] = acc[r]; }
            }
            __syncthreads();
        } else if (item < I_WAB) {
            const int i = item - I_WIN, kt = i & 7, nt = i >> 3;
            int nsrc = nt * 64;
            if (nsrc >= OFF_MA) { const int q = nsrc - OFF_MA, j = q >> 8, wi = q & 255; nsrc = ((wi >> 7) ? OFF_MB : OFF_MA) + j * 128 + (wi & 127); }
            else if (nsrc >= 2048) nsrc = OFF_V + (nsrc - 2048);
            else if (nsrc >= 1024) { const int q = nsrc - 1024, g = q >> 8, wi = q & 255; nsrc = ((wi >> 7) ? OFF_GB : OFF_U) + g * 128 + (wi & 127); }
            transpose_tile(lds, a.in[8] + nsrc, DIN, (bf16_t*)(ws + WS_WIN) + (size_t)(nt * 64) * D, D, kt * 128, 0);
        } else if (item < I_WO) {
            const int i = item - I_WAB, half = i >> 6, j = i & 63, kt = j & 3, nt = j >> 2;
            transpose_tile(lds, half ? a.in[17] : a.in[16], D, (bf16_t*)(ws + WS_WAB) + half * 512, D, kt * 128, nt * 64);
        } else if (item < I_PW) {
            const int i = item - I_WO, kt = i & 7, nt = i >> 3;
            transpose_tile(lds, a.in[18], D, (bf16_t*)(ws + WS_WO), D, kt * 128, nt * 64);
        } else if (item < I_SW) {
            const int i = item - I_PW, g = i >> 1, nt = i & 1;
            transpose_tile(lds, a.in[9] + g * 16384, 128, (bf16_t*)(ws + WS_PW) + g * 16384, 128, 0, nt * 64);
        } else {
            const int i = item - I_SW, idx = i * 4096 + tid * 8, t = (idx >> 7) & 127, s0 = idx & 127;
            const f32x4 v0 = *(const f32x4*)(a.in[14] + idx), v1 = *(const f32x4*)(a.in[14] + idx + 4);
            u32x4 w;
            w.x = pk_bf16(s0 + 0 <= t ? v0[0] : 0.f, s0 + 1 <= t ? v0[1] : 0.f); w.y = pk_bf16(s0 + 2 <= t ? v0[2] : 0.f, s0 + 3 <= t ? v0[3] : 0.f);
            w.z = pk_bf16(s0 + 4 <= t ? v1[0] : 0.f, s0 + 5 <= t ? v1[1] : 0.f); w.w = pk_bf16(s0 + 6 <= t ? v1[2] : 0.f, s0 + 7 <= t ? v1[3] : 0.f);
            *(u32x4*)((bf16_t*)(ws + WS_SW) + idx) = w;
        }
    }
}

__device__ __forceinline__ void h_row(const float* xr, bf16_t* hr, const f32x4 (&s1)[4], const f32x4 (&s0)[4], int lane) {
    f32x4 v[4]; float ss = 0.f;
#pragma unroll
    for (int q = 0; q < 4; ++q) { v[q] = *(const f32x4*)(xr + lane * 4 + 256 * q); ss += (v[q][0] * v[q][0] + v[q][1] * v[q][1]) + (v[q][2] * v[q][2] + v[q][3] * v[q][3]); }
    ss = wave_sum(ss);
    const float r = rsqrtf(ss * (1.0f / 1024.0f) + 1e-6f);
#pragma unroll
    for (int q = 0; q < 4; ++q) {
        const f32x4 h = (v[q] * r) * s1[q] + s0[q];
        u32x2 w; w.x = pk_bf16(h[0], h[1]); w.y = pk_bf16(h[2], h[3]);
        *(u32x2*)(hr + lane * 4 + 256 * q) = w;
    }
}

__device__ __forceinline__ void p1_load(const Args& a, f32x4 (&xv)[8][4], float (&xr)[8]) {
    int tid_ = threadIdx.x; asm volatile("" : "+v"(tid_));
    const int tid = tid_, wid = tid >> 6, lane = tid & 63;
    const float* xb = a.in[0] + (size_t)(BID * 64 + wid * 8) * D + lane * 4;
#pragma unroll
    for (int j = 0; j < 8; ++j)
#pragma unroll
        for (int q = 0; q < 4; ++q) xv[j][q] = *(const f32x4*)(xb + (size_t)j * D + 256 * q);
#pragma unroll
    for (int j = 0; j < 8; ++j) {
        float ss = 0.f;
#pragma unroll
        for (int q = 0; q < 4; ++q) ss += (xv[j][q][0] * xv[j][q][0] + xv[j][q][1] * xv[j][q][1]) + (xv[j][q][2] * xv[j][q][2] + xv[j][q][3] * xv[j][q][3]);
        ss = wave_sum(ss);
        xr[j] = rsqrtf(ss * (1.0f / 1024.0f) + 1e-6f);
    }
}

__device__ __forceinline__ void p1_phase(const Args& a, LAS unsigned char* lds, const f32x4 (&xv)[8][4], const float (&xr)[8]) {
    int tid_ = threadIdx.x; asm volatile("" : "+v"(tid_));
    const int tid = tid_, wid = tid >> 6, lane = tid & 63;
    unsigned char* ws = a.ws;
    const float* modp = (const float*)(ws + WS_MODP);
    const float* b_ada = a.in[6]; const float* ngain = a.in[7];
    bf16_t* hb = (bf16_t*)(ws + WS_HB);
    LAS float* S1 = (LAS float*)lds; LAS float* S0 = S1 + 1024;
    {
        const int blk = BID, b = blk >> 5;
        __syncthreads();
        for (int n = tid; n < D; n += NTHR) {
            float sh = b_ada[n], sc = b_ada[D + n];
#pragma unroll
            for (int ks = 0; ks < KS_MOD; ++ks) { sh += modp[((size_t)ks * NROWC + b) * NMOD + n]; sc += modp[((size_t)ks * NROWC + b) * NMOD + D + n]; }
            S1[n] = (1.0f + sc) * ngain[n]; S0[n] = sh;
        }
        __syncthreads();
        f32x4 s1[4], s0[4];
#pragma unroll
        for (int q = 0; q < 4; ++q) { s1[q] = *(const LAS f32x4*)(S1 + lane * 4 + 256 * q); s0[q] = *(const LAS f32x4*)(S0 + lane * 4 + 256 * q); }
        bf16_t* hr = hb + (size_t)(blk * 64 + wid * 8) * D + lane * 4;
#pragma unroll
        for (int j = 0; j < 8; ++j)
#pragma unroll
            for (int q = 0; q < 4; ++q) {
                const f32x4 h = (xv[j][q] * xr[j]) * s1[q] + s0[q];
                u32x2 w; w.x = pk_bf16(h[0], h[1]); w.y = pk_bf16(h[2], h[3]);
                *(u32x2*)(hr + (size_t)j * D + 256 * q) = w;
            }
    }
    for (int j = BID * 8 + wid; j < MS; j += (int)gridDim.x * 8) {
        f32x4 s1[4], s0[4];
#pragma unroll
        for (int q = 0; q < 4; ++q) {
            const int n = lane * 4 + 256 * q;
            f32x4 sh = *(const f32x4*)(b_ada + n), sc = *(const f32x4*)(b_ada + D + n);
#pragma unroll
            for (int ks = 0; ks < KS_MOD; ++ks) {
                sh += *(const f32x4*)(modp + ((size_t)ks * NROWC + NB + j) * NMOD + n);
                sc += *(const f32x4*)(modp + ((size_t)ks * NROWC + NB + j) * NMOD + D + n);
            }
            s1[q] = (sc + 1.0f) * *(const f32x4*)(ngain + n); s0[q] = sh;
        }
        h_row(a.in[1] + (size_t)j * D, hb + (size_t)(MPR + j) * D, s1, s0, lane);
    }
    float* gate = (float*)(ws + WS_GATE);
    for (int r = BID; r < NROWC; r += gridDim.x)
        for (int n = tid; n < D; n += NTHR) {
            float g = b_ada[2 * D + n];
#pragma unroll
            for (int ks = 0; ks < KS_MOD; ++ks) g += modp[((size_t)ks * NROWC + r) * NMOD + 2 * D + n];
            gate[(size_t)r * D + n] = g;
        }
}

constexpr int LP = 136;
__device__ __forceinline__ void unpack8(const u32x4 v, f32x4& lo, f32x4& hi) {
    lo = (f32x4){bf_lo(v.x), bf_hi(v.x), bf_lo(v.y), bf_hi(v.y)}; hi = (f32x4){bf_lo(v.z), bf_hi(v.z), bf_lo(v.w), bf_hi(v.w)};
}
__device__ __forceinline__ u32x4 pack8(const f32x4 lo, const f32x4 hi) {
    u32x4 w; w.x = pk_bf16(lo[0], lo[1]); w.y = pk_bf16(lo[2], lo[3]); w.z = pk_bf16(hi[0], hi[1]); w.w = pk_bf16(hi[2], hi[3]); return w;
}

__device__ __forceinline__ void p3_phase(const Args& a, LAS unsigned char* lds, int item0, int item_end, int item_step) {
    unsigned char* ws = a.ws;
    const bf16_t* Z = (const bf16_t*)(ws + WS_Z);
    bf16_t* YAB = (bf16_t*)(ws + WS_YAB);
    const bf16_t* PW = (const bf16_t*)(ws + WS_PW);
    const bf16_t* SW = (const bf16_t*)(ws + WS_SW);
    const float* stats = (const float*)(ws + WS_STATS);
    float* out = a.out;
    LAS bf16_t* Xs = (LAS bf16_t*)lds;
    LAS bf16_t* Ys = (LAS bf16_t*)(lds + 34816);
    LAS bf16_t* Es = (LAS bf16_t*)(lds + 69632);
    for (int item = item0; item < item_end; item += item_step) {
        int tid_ = threadIdx.x; asm volatile("" : "+v"(tid_));
        const int tid = tid_, wid = tid >> 6, lane = tid & 63, fr = lane & 15, fq = lane >> 4, pr = tid >> 4, pc = tid & 15;
        const int tile = item < 8 ? 128 : (item >> 3) - 1, sub = ((item & 7) + (item >> 3)) & 7, g = sub & 3;
        const bool isB = sub >= 4, sample = tile == 128;
        const int row0 = tile * 128, b = tile >> 4, n = tile & 15;
        const int t = wid * 16 + fr;
        const size_t row = (size_t)(row0 + t);
        const bf16_t* zt = Z + (size_t)tile * NCG * ZBLK;
        u32x2 e0[8];
        __syncthreads();
        if (!isB) {
            const int w = 2 << g;
            u32x4 pwv[4];
#pragma unroll
            for (int i = 0; i < 4; ++i) { const int p = tid + NTHR * i; pwv[i] = *(const u32x4*)(PW + g * 16384 + p * 8); }
#pragma unroll
            for (int ct = 0; ct < 8; ++ct) e0[ct] = *(const u32x2*)(zt + (4 + g) * ZBLK + t * 128 + ct * 16 + fq * 4);
            if (!sample) {
                u32x4 ev[5];
#pragma unroll
                for (int i = 0; i < 5; ++i) {
                    const int p = tid + NTHR * i;
                    ev[i] = (u32x4){0u, 0u, 0u, 0u};
                    if (p < 16 * 16) { if (n > 0) ev[i] = *(const u32x4*)(zt - (size_t)NCG * ZBLK + g * ZBLK + (112 * 16 + p) * 8); }
                    else if (p < 144 * 16) ev[i] = *(const u32x4*)(zt + g * ZBLK + (p - 256) * 8);
                }
#pragma unroll
                for (int i = 0; i < 4; ++i) { const int p = tid + NTHR * i, r = p >> 4, c = p & 15; *(LAS u32x4*)(Xs + r * LP + ((c ^ ((r >> 3) & 15)) << 3)) = pwv[i]; }
#pragma unroll
                for (int i = 0; i < 5; ++i) { const int p = tid + NTHR * i, r = p >> 4, c = p & 15; if (p < 144 * 16) *(LAS u32x4*)(Es + r * LP + c * 8) = ev[i]; }
                __syncthreads();
                {
                    f32x4 s_lo = (f32x4){0.f, 0.f, 0.f, 0.f}, s_hi = s_lo;
                    for (int j = 1; j < w; ++j) {
                        f32x4 lo, hi; unpack8(*(const LAS u32x4*)(Es + (16 + pr * 4 - j) * LP + pc * 8), lo, hi);
                        s_lo += lo; s_hi += hi;
                    }
#pragma unroll 1
                    for (int i = 0; i < 4; ++i) {
                        const int tt = pr * 4 + i;
                        f32x4 a_lo, a_hi; unpack8(*(const LAS u32x4*)(Es + (16 + tt) * LP + pc * 8), a_lo, a_hi);
                        s_lo += a_lo; s_hi += a_hi;
                        const int cnt = min(n * 128 + tt + 1, w);
                        const float inv = 1.0f / (float)cnt;
                        *(LAS u32x4*)(Ys + tt * LP + pc * 8) = pack8(s_lo * inv - a_lo, s_hi * inv - a_hi);
                        if (n == 15 && tt >= 113) {
                            float* o = out + O_PP + ((size_t)(b * 15 + (tt - 113)) * 512 + g * 128 + pc * 8);
                            *(f32x4*)o = a_lo; *(f32x4*)(o + 4) = a_hi;
                        }
                        f32x4 d_lo, d_hi; unpack8(*(const LAS u32x4*)(Es + (16 + tt + 1 - w) * LP + pc * 8), d_lo, d_hi);
                        s_lo -= d_lo; s_hi -= d_hi;
                    }
                }
            } else {
#pragma unroll
                for (int i = 0; i < 4; ++i) { const int p = tid + NTHR * i, r = p >> 4, c = p & 15; *(LAS u32x4*)(Xs + r * LP + ((c ^ ((r >> 3) & 15)) << 3)) = pwv[i]; }
                const float* presum = (const float*)(ws + WS_PRESUM);
                const float inv = 1.0f / (float)w;
#pragma unroll 1
                for (int pass = 0; pass < 4; ++pass) {
                    const int r = pass * 32 + pr;
                    f32x4 a_lo, a_hi; unpack8(*(const u32x4*)(zt + g * ZBLK + r * 128 + pc * 8), a_lo, a_hi);
                    const f32x4 p_lo = *(const f32x4*)(presum + (size_t)r * 512 + g * 128 + pc * 8), p_hi = *(const f32x4*)(presum + (size_t)r * 512 + g * 128 + pc * 8 + 4);
                    float* o = out + O_PS + ((size_t)r * 15 + 14) * 512 + g * 128 + pc * 8;
                    *(f32x4*)o = a_lo; *(f32x4*)(o + 4) = a_hi;
                    *(LAS u32x4*)(Ys + r * LP + pc * 8) = pack8((a_lo + p_lo) * inv - a_lo, (a_hi + p_hi) * inv - a_hi);
                }
            }
            __syncthreads();
        } else {
            u32x4 vv[4]; f32x2 st[4];
#pragma unroll
            for (int i = 0; i < 4; ++i) { const int p = tid + NTHR * i; vv[i] = *(const u32x4*)(zt + (12 + g) * ZBLK + p * 8); st[i] = *(const f32x2*)(stats + (size_t)(row0 + (p >> 4)) * 2); }
            const int ch = g * 128 + pc * 8;
            const f32x4 lg0 = *(const f32x4*)(a.in[12] + ch), lg1 = *(const f32x4*)(a.in[12] + ch + 4), lb0 = *(const f32x4*)(a.in[13] + ch), lb1 = *(const f32x4*)(a.in[13] + ch + 4);
            if (!sample) {
                u32x4 wv[4];
#pragma unroll
                for (int i = 0; i < 4; ++i) { const int p = tid + NTHR * i; wv[i] = *(const u32x4*)(SW + g * 16384 + p * 8); }
#pragma unroll
                for (int ct = 0; ct < 8; ++ct) e0[ct] = *(const u32x2*)(zt + (8 + g) * ZBLK + t * 128 + ct * 16 + fq * 4);
#pragma unroll
                for (int i = 0; i < 4; ++i) { const int p = tid + NTHR * i, r = p >> 4, c = p & 15; *(LAS u32x4*)(Ys + r * LP + c * 8) = wv[i]; }
#pragma unroll
                for (int i = 0; i < 4; ++i) {
                    const int s_ = pr + 32 * i;
                    const float mu = st[i].x * (1.0f / 512.0f), rstd = rsqrtf(fmaxf(st[i].y * (1.0f / 512.0f) - mu * mu, 0.f) + 1e-6f);
                    f32x4 lo, hi; unpack8(vv[i], lo, hi);
                    const f32x4 vlo = (lo - mu) * rstd * lg0 + lb0, vhi = (hi - mu) * rstd * lg1 + lb1;
                    const u32x4 pk = pack8(vlo, vhi);
                    LAS bf16_t* xp = Xs + (pc * 8) * LP + ((((s_ >> 3) ^ pc) << 3) | (s_ & 7));
                    xp[0 * LP] = (bf16_t)(pk.x & 0xffffu); xp[1 * LP] = (bf16_t)(pk.x >> 16); xp[2 * LP] = (bf16_t)(pk.y & 0xffffu); xp[3 * LP] = (bf16_t)(pk.y >> 16);
                    xp[4 * LP] = (bf16_t)(pk.z & 0xffffu); xp[5 * LP] = (bf16_t)(pk.z >> 16); xp[6 * LP] = (bf16_t)(pk.w & 0xffffu); xp[7 * LP] = (bf16_t)(pk.w >> 16);
                    if (n == 15) { float* o = out + O_VP + ((size_t)(b * 128 + s_) * 512 + ch); *(f32x4*)o = vlo; *(f32x4*)(o + 4) = vhi; }
                }
            } else {
                const float w00 = a.in[14][g * 16384], sb0 = a.in[15][g * 128];
#pragma unroll
                for (int i = 0; i < 4; ++i) {
                    const int s_ = pr + 32 * i;
                    const float mu = st[i].x * (1.0f / 512.0f), rstd = rsqrtf(fmaxf(st[i].y * (1.0f / 512.0f) - mu * mu, 0.f) + 1e-6f);
                    f32x4 lo, hi; unpack8(vv[i], lo, hi);
                    const f32x4 vlo = (lo - mu) * rstd * lg0 + lb0, vhi = (hi - mu) * rstd * lg1 + lb1;
                    f32x4 ulo, uhi;
                    unpack8(*(const u32x4*)(zt + (8 + g) * ZBLK + s_ * 128 + pc * 8), ulo, uhi);
                    const f32x4 ylo = ulo * (vlo * w00 + sb0), yhi = uhi * (vhi * w00 + sb0);
                    *(u32x4*)(YAB + (size_t)(MPR + s_) * D + 512 + ch) = pack8(ylo, yhi);
                    float* o = out + O_VS + (size_t)s_ * 512 + ch; *(f32x4*)o = vlo; *(f32x4*)(o + 4) = vhi;
                }
            }
            __syncthreads();
            if (sample) continue;
        }
        f32x4 pbv[8], psv[8];
        if (!isB) {
#pragma unroll
            for (int ct = 0; ct < 8; ++ct) { pbv[ct] = *(const f32x4*)(a.in[10] + g * 128 + ct * 16 + fq * 4); psv[ct] = *(const f32x4*)(a.in[11] + g * 128 + ct * 16 + fq * 4); }
        }
        f32x4 acc[8];
#pragma unroll
        for (int ct = 0; ct < 8; ++ct) acc[ct] = (f32x4){0.f, 0.f, 0.f, 0.f};
        bf16x8 yf[4];
#pragma unroll
        for (int ks = 0; ks < 4; ++ks) yf[ks] = *(const LAS bf16x8*)(Ys + (wid * 16 + fr) * LP + ks * 32 + fq * 8);
#pragma unroll
        for (int ct = 0; ct < 8; ++ct)
#pragma unroll
            for (int ks = 0; ks < 4; ++ks) {
                const bf16x8 xf = *(const LAS bf16x8*)(Xs + (ct * 16 + fr) * LP + (((ks * 4 + fq) ^ (ct * 2 + (fr >> 3))) << 3));
                acc[ct] = __builtin_amdgcn_mfma_f32_16x16x32_bf16(xf, yf[ks], acc[ct], 0, 0, 0);
            }
        if (!isB) {
#pragma unroll
            for (int ct = 0; ct < 8; ++ct) {
                const int ch = g * 128 + ct * 16 + fq * 4;
                const f32x4 pb = pbv[ct], ps = psv[ct];
                const u32x2 gv = e0[ct];
                const f32x4 ga = (f32x4){bf_lo(gv.x), bf_hi(gv.x), bf_lo(gv.y), bf_hi(gv.y)};
                const f32x4 v = (acc[ct] + pb) * ps * ga;
                u32x2 wq; wq.x = pk_bf16(v[0], v[1]); wq.y = pk_bf16(v[2], v[3]);
                *(u32x2*)(YAB + row * D + ch) = wq;
            }
        } else {
            const float sbt = a.in[15][g * 128 + t];
#pragma unroll
            for (int ct = 0; ct < 8; ++ct) {
                const int ch = g * 128 + ct * 16 + fq * 4;
                const u32x2 uv = e0[ct];
                const f32x4 uu = (f32x4){bf_lo(uv.x), bf_hi(uv.x), bf_lo(uv.y), bf_hi(uv.y)};
                const f32x4 v = uu * (acc[ct] + sbt);
                u32x2 wq; wq.x = pk_bf16(v[0], v[1]); wq.y = pk_bf16(v[2], v[3]);
                *(u32x2*)(YAB + row * D + 512 + ch) = wq;
            }
        }
    }
}

#define P3_DECODE(it, tile_, g_, isB_) const int tile_ = ((it) >> 3) - 1, sub_##tile_ = (((it) & 7) + ((it) >> 3)) & 7, g_ = sub_##tile_ & 3; const bool isB_ = sub_##tile_ >= 4
#define P3_PREFETCH(it) do { \
        P3_DECODE(it, tl_, gg_, ib_); \
        const bf16_t* zz_ = Z + (size_t)tl_ * NCG * ZBLK; const int tt_ = wid * 16 + fr; \
        if (!ib_) { \
            _Pragma("unroll") for (int i = 0; i < 4; ++i) L[i] = *(const u32x4*)(PW + gg_ * 16384 + (tid + NTHR * i) * 8); \
            _Pragma("unroll") for (int i = 0; i < 5; ++i) { const int p = tid + NTHR * i; L[4 + i] = (u32x4){0u, 0u, 0u, 0u}; \
                if (p < 16 * 16) { if ((tl_ & 15) > 0) L[4 + i] = *(const u32x4*)(zz_ - (size_t)NCG * ZBLK + gg_ * ZBLK + (112 * 16 + p) * 8); } \
                else if (p < 144 * 16) L[4 + i] = *(const u32x4*)(zz_ + gg_ * ZBLK + (p - 256) * 8); } \
            _Pragma("unroll") for (int ct = 0; ct < 8; ++ct) E[ct] = *(const u32x2*)(zz_ + (4 + gg_) * ZBLK + tt_ * 128 + ct * 16 + fq * 4); \
        } else { \
            _Pragma("unroll") for (int i = 0; i < 4; ++i) { const int p = tid + NTHR * i; L[i] = *(const u32x4*)(zz_ + (12 + gg_) * ZBLK + p * 8); ST[i] = *(const f32x2*)(stats + (size_t)(tl_ * 128 + (p >> 4)) * 2); \
                L[4 + i] = *(const u32x4*)(SW + gg_ * 16384 + p * 8); } \
            _Pragma("unroll") for (int ct = 0; ct < 8; ++ct) E[ct] = *(const u32x2*)(zz_ + (8 + gg_) * ZBLK + tt_ * 128 + ct * 16 + fq * 4); \
        } } while (0)

__device__ __forceinline__ void p3_pipelined(const Args& a, LAS unsigned char* lds, int item0, int item_step, int cnt) {
    unsigned char* ws = a.ws;
    const bf16_t* Z = (const bf16_t*)(ws + WS_Z);
    bf16_t* YAB = (bf16_t*)(ws + WS_YAB);
    const bf16_t* PW = (const bf16_t*)(ws + WS_PW);
    const bf16_t* SW = (const bf16_t*)(ws + WS_SW);
    const float* stats = (const float*)(ws + WS_STATS);
    float* out = a.out;
    LAS bf16_t* Xs = (LAS bf16_t*)lds;
    LAS bf16_t* Ys = (LAS bf16_t*)(lds + 34816);
    LAS bf16_t* Es = (LAS bf16_t*)(lds + 69632);
    if (cnt <= 0) return;
    u32x4 L[9]; u32x2 E[8]; f32x2 ST[4];
    {
        int tid_ = threadIdx.x; asm volatile("" : "+v"(tid_));
        const int tid = tid_, wid = tid >> 6, lane = tid & 63, fr = lane & 15, fq = lane >> 4;
        P3_PREFETCH(item0);
    }
    for (int k = 0; k < cnt; ++k) {
        const int item = item0 + k * item_step;
        int tid_ = threadIdx.x; asm volatile("" : "+v"(tid_));
        const int tid = tid_, wid = tid >> 6, lane = tid & 63, fr = lane & 15, fq = lane >> 4, pr = tid >> 4, pc = tid & 15;
        P3_DECODE(item, tile, g, isB);
        const int row0 = tile * 128, b = tile >> 4, n = tile & 15;
        const int t = wid * 16 + fr;
        const size_t row = (size_t)(row0 + t);
        __syncthreads();
        if (!isB) {
            const int w = 2 << g;
#pragma unroll
            for (int i = 0; i < 4; ++i) { const int p = tid + NTHR * i, r = p >> 4, c = p & 15; *(LAS u32x4*)(Xs + r * LP + ((c ^ ((r >> 3) & 15)) << 3)) = L[i]; }
#pragma unroll
            for (int i = 0; i < 5; ++i) { const int p = tid + NTHR * i, r = p >> 4, c = p & 15; if (p < 144 * 16) *(LAS u32x4*)(Es + r * LP + c * 8) = L[4 + i]; }
            __syncthreads();
            {
                f32x4 s_lo = (f32x4){0.f, 0.f, 0.f, 0.f}, s_hi = s_lo;
                for (int j = 1; j < w; ++j) {
                    f32x4 lo, hi; unpack8(*(const LAS u32x4*)(Es + (16 + pr * 4 - j) * LP + pc * 8), lo, hi);
                    s_lo += lo; s_hi += hi;
                }
#pragma unroll 1
                for (int i = 0; i < 4; ++i) {
                    const int tt = pr * 4 + i;
                    f32x4 a_lo, a_hi; unpack8(*(const LAS u32x4*)(Es + (16 + tt) * LP + pc * 8), a_lo, a_hi);
                    s_lo += a_lo; s_hi += a_hi;
                    const int cnt = min(n * 128 + tt + 1, w);
                    const float inv = 1.0f / (float)cnt;
                    *(LAS u32x4*)(Ys + tt * LP + pc * 8) = pack8(s_lo * inv - a_lo, s_hi * inv - a_hi);
                    if (n == 15 && tt >= 113) {
                        float* o = out + O_PP + ((size_t)(b * 15 + (tt - 113)) * 512 + g * 128 + pc * 8);
                        *(f32x4*)o = a_lo; *(f32x4*)(o + 4) = a_hi;
                    }
                    f32x4 d_lo, d_hi; unpack8(*(const LAS u32x4*)(Es + (16 + tt + 1 - w) * LP + pc * 8), d_lo, d_hi);
                    s_lo -= d_lo; s_hi -= d_hi;
                }
            }
        } else {
            const int ch = g * 128 + pc * 8;
            const f32x4 lg0 = *(const f32x4*)(a.in[12] + ch), lg1 = *(const f32x4*)(a.in[12] + ch + 4), lb0 = *(const f32x4*)(a.in[13] + ch), lb1 = *(const f32x4*)(a.in[13] + ch + 4);
#pragma unroll
            for (int i = 0; i < 4; ++i) { const int p = tid + NTHR * i, r = p >> 4, c = p & 15; *(LAS u32x4*)(Ys + r * LP + c * 8) = L[4 + i]; }
#pragma unroll
            for (int i = 0; i < 4; ++i) {
                const int s_ = pr + 32 * i;
                const float mu = ST[i].x * (1.0f / 512.0f), rstd = rsqrtf(fmaxf(ST[i].y * (1.0f / 512.0f) - mu * mu, 0.f) + 1e-6f);
                f32x4 lo, hi; unpack8(L[i], lo, hi);
                const f32x4 vlo = (lo - mu) * rstd * lg0 + lb0, vhi = (hi - mu) * rstd * lg1 + lb1;
                const u32x4 pk = pack8(vlo, vhi);
                LAS bf16_t* xp = Xs + (pc * 8) * LP + ((((s_ >> 3) ^ pc) << 3) | (s_ & 7));
                xp[0 * LP] = (bf16_t)(pk.x & 0xffffu); xp[1 * LP] = (bf16_t)(pk.x >> 16); xp[2 * LP] = (bf16_t)(pk.y & 0xffffu); xp[3 * LP] = (bf16_t)(pk.y >> 16);
                xp[4 * LP] = (bf16_t)(pk.z & 0xffffu); xp[5 * LP] = (bf16_t)(pk.z >> 16); xp[6 * LP] = (bf16_t)(pk.w & 0xffffu); xp[7 * LP] = (bf16_t)(pk.w >> 16);
                if (n == 15) { float* o = out + O_VP + ((size_t)(b * 128 + s_) * 512 + ch); *(f32x4*)o = vlo; *(f32x4*)(o + 4) = vhi; }
            }
        }
        __syncthreads();
        u32x2 Ec[8];
#pragma unroll
        for (int ct = 0; ct < 8; ++ct) Ec[ct] = E[ct];
        f32x4 pbv[8], psv[8]; float sbt = 0.f;
        if (!isB) {
#pragma unroll
            for (int ct = 0; ct < 8; ++ct) { pbv[ct] = *(const f32x4*)(a.in[10] + g * 128 + ct * 16 + fq * 4); psv[ct] = *(const f32x4*)(a.in[11] + g * 128 + ct * 16 + fq * 4); }
        } else sbt = a.in[15][g * 128 + t];
        if (k + 1 < cnt) P3_PREFETCH(item + item_step);
        f32x4 acc[8];
#pragma unroll
        for (int ct = 0; ct < 8; ++ct) acc[ct] = (f32x4){0.f, 0.f, 0.f, 0.f};
        bf16x8 yf[4];
#pragma unroll
        for (int ks = 0; ks < 4; ++ks) yf[ks] = *(const LAS bf16x8*)(Ys + (wid * 16 + fr) * LP + ks * 32 + fq * 8);
#pragma unroll
        for (int ct = 0; ct < 8; ++ct)
#pragma unroll
            for (int ks = 0; ks < 4; ++ks) {
                const bf16x8 xf = *(const LAS bf16x8*)(Xs + (ct * 16 + fr) * LP + (((ks * 4 + fq) ^ (ct * 2 + (fr >> 3))) << 3));
                acc[ct] = __builtin_amdgcn_mfma_f32_16x16x32_bf16(xf, yf[ks], acc[ct], 0, 0, 0);
            }
        if (!isB) {
#pragma unroll
            for (int ct = 0; ct < 8; ++ct) {
                const int ch = g * 128 + ct * 16 + fq * 4;
                const u32x2 gv = Ec[ct];
                const f32x4 ga = (f32x4){bf_lo(gv.x), bf_hi(gv.x), bf_lo(gv.y), bf_hi(gv.y)};
                const f32x4 v = (acc[ct] + pbv[ct]) * psv[ct] * ga;
                u32x2 wq; wq.x = pk_bf16(v[0], v[1]); wq.y = pk_bf16(v[2], v[3]);
                *(u32x2*)(YAB + row * D + ch) = wq;
            }
        } else {
#pragma unroll
            for (int ct = 0; ct < 8; ++ct) {
                const int ch = g * 128 + ct * 16 + fq * 4;
                const u32x2 uv = Ec[ct];
                const f32x4 uu = (f32x4){bf_lo(uv.x), bf_hi(uv.x), bf_lo(uv.y), bf_hi(uv.y)};
                const f32x4 v = uu * (acc[ct] + sbt);
                u32x2 wq; wq.x = pk_bf16(v[0], v[1]); wq.y = pk_bf16(v[2], v[3]);
                *(u32x2*)(YAB + row * D + 512 + ch) = wq;
            }
        }
    }
}
#undef P3_PREFETCH
#undef P3_DECODE

template <int MODE>
__device__ __forceinline__ void sample_gemm(const Args& a, LAS unsigned char* lds) {
    int tid_ = threadIdx.x; asm volatile("" : "+v"(tid_));
    const int tid = tid_, wid = tid >> 6, lane = tid & 63, fr = lane & 15, fq = lane >> 4, rtile = wid & 1, ks = wid >> 1;
    unsigned char* ws = a.ws;
    const bf16_t* A = MODE == 0 ? (const bf16_t*)(ws + WS_YAB) + (size_t)MPR * D : (const bf16_t*)(ws + WS_HB) + (size_t)MPR * D;
    const bf16_t* Wt = MODE == 0 ? (const bf16_t*)(ws + WS_WAB) : (const bf16_t*)(ws + WS_WO);
    LAS f32x4* red = (LAS f32x4*)lds;
    for (int item = BID; item < 256; item += gridDim.x) {
        const int rt = item & 3, ct = item >> 2;
        const bf16_t* ap = A + (size_t)(rt * 32 + rtile * 16 + fr) * D + ks * 256 + fq * 8;
        const bf16_t* wp = Wt + (size_t)(ct * 16 + fr) * D + ks * 256 + fq * 8;
        bf16x8 xa[8], xw[8];
#pragma unroll
        for (int s = 0; s < 8; ++s) { xa[s] = *(const bf16x8*)(ap + s * 32); xw[s] = *(const bf16x8*)(wp + s * 32); }
        const int row = rt * 32 + (wid & 1) * 16 + fr, col = ct * 16 + fq * 4;
        u32x2 esa = (u32x2){0u, 0u}, esb = esa; f32x4 exv = (f32x4){0.f, 0.f, 0.f, 0.f}, egv = exv;
        if (wid < 2) {
            if (MODE == 0) {
                const bf16_t* zr = (const bf16_t*)(ws + WS_Z) + ((size_t)128 * NCG + 20 + 2 * (col >> 7)) * ZBLK + row * 128 + (col & 127);
                esa = *(const u32x2*)(zr); esb = *(const u32x2*)(zr + ZBLK);
            } else {
                exv = *(const f32x4*)(a.in[1] + (size_t)row * D + col);
                egv = *(const f32x4*)((const float*)(ws + WS_GATE) + (size_t)(NB + row) * D + col);
            }
        }
        f32x4 acc = (f32x4){0.f, 0.f, 0.f, 0.f};
#pragma unroll
        for (int s = 0; s < 8; ++s) acc = __builtin_amdgcn_mfma_f32_16x16x32_bf16(xw[s], xa[s], acc, 0, 0, 0);
        __syncthreads();
        red[wid * 64 + lane] = acc;
        __syncthreads();
        if (wid < 2) {
            const f32x4 p0 = red[(0 + wid) * 64 + lane], p1 = red[(2 + wid) * 64 + lane], p2 = red[(4 + wid) * 64 + lane], p3 = red[(6 + wid) * 64 + lane];
            if (MODE == 0) {
                const f32x4 fa = (f32x4){bf_lo(esa.x), bf_hi(esa.x), bf_lo(esa.y), bf_hi(esa.y)}, fb = (f32x4){bf_lo(esb.x), bf_hi(esb.x), bf_lo(esb.y), bf_hi(esb.y)};
                const f32x4 v = fb * (fa * (p0 + p1) + (p2 + p3));
                u32x2 w; w.x = pk_bf16(v[0], v[1]); w.y = pk_bf16(v[2], v[3]);
                *(u32x2*)((bf16_t*)(ws + WS_HB) + (size_t)(MPR + row) * D + col) = w;
            } else {
                *(f32x4*)((float*)(ws + WS_XS) + (size_t)row * D + col) = exv + egv * ((p0 + p1) + (p2 + p3));
            }
        }
    }
    __syncthreads();
}

__global__ void __launch_bounds__(NTHR, 2) fwd_kernel(Args a) {
    extern __shared__ __attribute__((aligned(16))) unsigned char lds_raw[];
    LAS unsigned char* lds = (LAS unsigned char*)lds_raw;
    unsigned char* ws = a.ws;
    if (ws == nullptr) cg::this_grid().sync();
    if (threadIdx.x < 4) ((LAS unsigned*)(lds + LDS_BAR_OFF))[threadIdx.x] = 0u;
    __syncthreads();
    (void)xcd_barrier_post((unsigned*)(ws + WS_BAR), (volatile LAS unsigned*)(lds + LDS_BAR_OFF));
#define GRID_BAR() do { XcdBarrier b_; b_.bar = (unsigned*)(a.ws + WS_BAR); b_.x = xb_xcc_id(); b_.st = (volatile LAS unsigned*)(lds + LDS_BAR_OFF); xcd_barrier(b_); } while (0)

    p0_phase(a, lds);
    f32x4 xv[8][4]; float xr[8];
    p1_load(a, xv, xr);
    GRID_BAR();
    p1_phase(a, lds, xv, xr);
    GRID_BAR();
#pragma unroll 1
    for (int stage = 0; stage < 2; ++stage) {
        Gemm g{(const bf16_t*)(ws + WS_HB), (const bf16_t*)(ws + WS_WIN), MPAD, DIN, D, D / 64};
        OrderAB S{BID, stage};
        EpiZ E{(bf16_t*)(ws + WS_Z), (float*)(ws + WS_STATS)};
        gemm_phase<EpiZ, OrderAB>(lds, g, S, E);
        if (stage == 0) GRID_BAR();
    }
    {
        constexpr int NFREE = 256 - N_ORDER_B;
        const bool fre = BID >= N_ORDER_B;
        const int c = BID;
        if (!fre && c >= N_ORDER_B - 8) p3_phase(a, lds, c - (N_ORDER_B - 8), 8, 8);
        p3_pipelined(a, lds, fre ? 8 + (c - N_ORDER_B) : 8 + 660 + c, fre ? NFREE : N_ORDER_B, fre ? 6 : (c < 72 ? 3 : 2));
    }
    GRID_BAR();
    {
        sample_gemm<0>(a, lds);
        Gemm g{(const bf16_t*)(ws + WS_YAB), (const bf16_t*)(ws + WS_WAB), MPR, D, D, 8};
        OrderK2 S; S.so.init(MPR, D, (int)gridDim.x, BID);
        EpiMerged E{(const bf16_t*)(ws + WS_Z), (bf16_t*)(ws + WS_HB)};
        gemm_phase<EpiMerged, OrderK2>(lds, g, S, E);
    }
    GRID_BAR();
    {
        sample_gemm<1>(a, lds);
        Gemm g{(const bf16_t*)(ws + WS_HB), (const bf16_t*)(ws + WS_WO), MPR, D, D, D / 64};
        StaticOrder S; S.init(MPR, D, (int)gridDim.x, BID);
        EpiFinal E{a.in[0], (const float*)(ws + WS_GATE), a.in[19], (float*)(ws + WS_RP), a.out + O_YP, (const float*)(ws + WS_XS), a.out + O_YS, (unsigned*)(ws + WS_BAR)};
        gemm_phase<EpiFinal, StaticOrder>(lds, g, S, E);
    }
}

extern "C" void kernel_launch(void* const* d_in, const int* in_sizes, int n_in, void* d_out, int out_size, void* d_ws, size_t ws_size, hipStream_t stream) {
    static int ready = 0;
    if (ready == 0) {
        ready = -1;
        if (n_in != 20 || in_sizes[0] != MPR * D || ws_size < WS_END) { fprintf(stderr, "kernel_launch: unexpected shapes (n_in %d, ws %zu, need %zu)\n", n_in, ws_size, (size_t)WS_END); return; }
        int dev = 0, cus = 0, per_cu = 0;
        if (hipGetDevice(&dev) != hipSuccess || hipDeviceGetAttribute(&cus, hipDeviceAttributeMultiprocessorCount, dev) != hipSuccess) { fprintf(stderr, "kernel_launch: device query failed\n"); return; }
        if (hipFuncSetAttribute((const void*)fwd_kernel, hipFuncAttributeMaxDynamicSharedMemorySize, LDS_BYTES) != hipSuccess) { fprintf(stderr, "kernel_launch: hipFuncSetAttribute failed\n"); return; }
        if (hipOccupancyMaxActiveBlocksPerMultiprocessor(&per_cu, (const void*)fwd_kernel, NTHR, LDS_BYTES) != hipSuccess) per_cu = 0;
        (void)hipGetLastError();
        if (cus * per_cu < 256) { fprintf(stderr, "kernel_launch: need 256 co-resident workgroups, device offers %d x %d\n", cus, per_cu); return; }
        ready = 1;
    }
    if (ready < 0) return;
    Args a{};
    for (int i = 0; i < 20; ++i) a.in[i] = (const float*)d_in[i];
    a.out = (float*)d_out; a.ws = (unsigned char*)d_ws;
    if (hipMemsetAsync((unsigned char*)d_ws + WS_BAR, 0, 16384, stream) != hipSuccess) { fprintf(stderr, "kernel_launch: memset failed\n"); return; }
    void* args[] = {&a};
    hipError_t e = hipLaunchCooperativeKernel((const void*)fwd_kernel, dim3(256), dim3(NTHR), args, LDS_BYTES, stream);
    if (e != hipSuccess) fprintf(stderr, "kernel_launch: cooperative launch failed: %s\n", hipGetErrorString(e));
}
```

```cpp
#include <hip/hip_runtime.h>
#include <hip/hip_cooperative_groups.h>
#include <cstdio>
namespace cg = cooperative_groups;

namespace pg8 {
#define PG8_LAS __attribute__((address_space(3)))
typedef unsigned short bf16_t;
typedef short bf16x8 __attribute__((ext_vector_type(8)));
typedef float f32x4 __attribute__((ext_vector_type(4)));
typedef unsigned u32x4 __attribute__((ext_vector_type(4)));
constexpr int BM = 256, BK = 64, HALF = 128, HTB = HALF * BK * 2  , STAGE_BYTES = 8 * HTB, NXCD = 8, WGM = 8;

__host__ __device__ __forceinline__ int lds_byte(int r, int c) { const int st = (r >> 4) * 2 + (c >> 5), rr = r & 15, cc = c & 31, ob = rr * 64 + cc * 2; return st * 1024 + (ob ^ (((ob >> 9) & 1) << 5)); }
__host__ __device__ __forceinline__ void stage_rc(int b, int& R, int& C) { const int st = b / 1024, sb = b % 1024, swz = sb ^ (((sb >> 9) & 1) << 5); R = (st >> 1) * 16 + swz / 64; C = (st & 1) * 32 + (swz % 64) / 2; }
__host__ __device__ __forceinline__ int perm32(int rho) { const int n = rho >> 4, i = rho & 15; return 8 * (i >> 2) + 4 * n + (i & 3); }

struct Unit { int pm, pn, kh = 0; };
struct Gemm { const bf16_t* A; const bf16_t* Bt; int M, N, K, KT; };

struct StaticOrder {
    int nM, nN, nwg, G, c;
    __host__ __device__ void init(int M, int N, int G_, int c_) { nM = M / BM; nN = N / BM; nwg = nM * nN; G = G_; c = c_; }
    __host__ __device__ bool next(int i, Unit& u) const {
        const long L = (long)i * G + c; if (L >= nwg) return false;
        int wgid = (int)L; { const int q = nwg / NXCD, r = nwg % NXCD, xcd = wgid % NXCD, off = wgid / NXCD; wgid = (xcd < r ? xcd * (q + 1) : r * (q + 1) + (xcd - r) * q) + off; }
        const int nig = WGM * nN, gid = wgid / nig, fm = gid * WGM, gsz = (nM - fm) < WGM ? (nM - fm) : WGM;
        u.pm = fm + ((wgid % nig) % gsz); u.pn = (wgid % nig) / gsz; return true;
    }
    __device__ __forceinline__ void a_ready(const Unit&) const {}
    __device__ __forceinline__ void done(const Unit&) const {}
};
__device__ __forceinline__ unsigned cvt_pk_bf16(float lo, float hi) { unsigned r; asm volatile("v_cvt_pk_bf16_f32 %0, %1, %2" : "=v"(r) : "v"(lo), "v"(hi)); return r; }
typedef float f32x2 __attribute__((ext_vector_type(2)));
__device__ __forceinline__ f32x2 gelu_pk(f32x2 v) {
    const f32x2 av = __builtin_elementwise_abs(v), d = av * 0.2316418882f + 1.0f;
    f32x2 t; t.x = __builtin_amdgcn_rcpf(d.x); t.y = __builtin_amdgcn_rcpf(d.y);
    f32x2 q = t * 0.5307027145f + (-0.7265760135f); q = q * t + 0.7107068705f; q = q * t + (-0.142248368f); q = q * t + 0.127414796f; q = q * t;
    const f32x2 s = (v * v) * (-0.72134752044f);
    f32x2 e; e.x = __builtin_amdgcn_exp2f(s.x); e.y = __builtin_amdgcn_exp2f(s.y);
    const f32x2 m = v * (q * e), r = v - m;
    f32x2 o; o.x = v.x < 0.f ? m.x : r.x; o.y = v.y < 0.f ? m.y : r.y; return o;
}

#define PG8_KBODY { \
            const bool last = (t == nt - 2); \
            const char* a1 = cA + (size_t)(t + 1) * kstep; \
            const char* a2 = last ? nA : cA + (size_t)(t + 2) * kstep; const char* b2 = last ? nB : cB + (size_t)(t + 2) * kstep; \
            const char* a3 = a2 + kstep; const char* b3 = b2 + kstep; \
            if (last && has_next) S.a_ready(nxt); \
            PG8_LDB(B0, 0, 0); PG8_SCHED; PG8_LDA(At, 0, 0); PG8_STAGE(PG8_SA(1, 1), a1 + hstep, voffA); \
            PG8_WAIT_L(8); PG8_BAR; PG8_WAIT_L(0); PG8_MMA(0, 0, At, B0); PG8_BAR; PG8_SCHED; \
            PG8_LDB(B1, 0, 1); PG8_STAGE(PG8_SB(0, 0), b2, voffB); \
            PG8_BAR; PG8_WAIT_L(0); PG8_MMA(0, 1, At, B1); PG8_BAR; \
            PG8_LDA(At, 0, 1); PG8_STAGE(PG8_SA(0, 0), a2, voffA); \
            PG8_BAR; PG8_WAIT_L(0); PG8_MMA(1, 0, At, B0); PG8_BAR; PG8_SCHED; \
            PG8_STAGE(PG8_SB(0, 1), b2 + hstep, voffB); \
            PG8_WAIT_V(6); PG8_BAR; PG8_MMA(1, 1, At, B1); PG8_BAR; \
            PG8_LDB(B0, 1, 0); PG8_SCHED; PG8_LDA(At, 1, 0); PG8_STAGE(PG8_SA(0, 1), a2 + hstep, voffA); \
            PG8_WAIT_L(8); PG8_BAR; PG8_WAIT_L(0); PG8_MMA(0, 0, At, B0); PG8_BAR; PG8_SCHED; \
            PG8_LDB(B1, 1, 1); PG8_STAGE(PG8_SB(1, 0), b3, voffB); \
            PG8_BAR; PG8_WAIT_L(0); PG8_MMA(0, 1, At, B1); PG8_BAR; \
            PG8_LDA(At, 1, 1); PG8_STAGE(PG8_SA(1, 0), a3, voffA); \
            PG8_BAR; PG8_WAIT_L(0); PG8_MMA(1, 0, At, B0); PG8_BAR; PG8_SCHED; \
            PG8_STAGE(PG8_SB(1, 1), b3 + hstep, voffB); \
            PG8_WAIT_V(6); PG8_BAR; PG8_MMA(1, 1, At, B1); PG8_BAR; \
        }
template <class Epi, class Sched>
__device__ __forceinline__ void gemm_phase(PG8_LAS unsigned char* lds, const Gemm g, const Sched& S, const Epi& E) {
    int tid_ = threadIdx.x; asm volatile("" : "+v"(tid_));
    const int tid = tid_, wid = __builtin_amdgcn_readfirstlane(tid >> 6), lane = tid & 63, wr = wid >> 2, wc = wid & 3, fr = lane & 15, fq = lane >> 4;
    const int K = g.K, nt = g.KT;
    unsigned voffA[2], voffB[2];
#pragma unroll
    for (int i = 0; i < 2; ++i) { int R, C; stage_rc(tid * 16 + i * 8192, R, C); const int Rb = Epi::PERM ? ((R & ~31) + perm32(R & 31)) : R;
        voffA[i] = (unsigned)(R * K + C) * 2u; voffB[i] = (unsigned)(Rb * K + C) * 2u; }
    const size_t kstep = (size_t)(BK * 2);
    const size_t hstep = (size_t)HALF * K * 2;
    const size_t tstep = 2 * hstep;
    const unsigned ldsw = (unsigned)wid * 1024u;
    const int aoff = lds_byte(wr * 64 + fr, fq * 8), boff = lds_byte(wc * 32 + fr, fq * 8);
#define PG8_SA(b, h) (((b) * 2 + (h)) * HTB)
#define PG8_SB(b, h) ((4 + (b) * 2 + (h)) * HTB)
#define PG8_STAGE(bufoff, gbase, voff) do { _Pragma("unroll") for (int _i = 0; _i < 2; ++_i) \
        __builtin_amdgcn_global_load_lds((const unsigned*)((const char*)(gbase) + (voff)[_i]), (PG8_LAS unsigned*)(lds + (bufoff) + ldsw + _i * 8192), 16, 0, 0); } while (0)
#define PG8_LDA(dst, b, h) do { _Pragma("unroll") for (int m = 0; m < 4; ++m) _Pragma("unroll") for (int k = 0; k < 2; ++k) dst[m][k] = *(const PG8_LAS bf16x8*)(lds + PG8_SA(b, h) + aoff + m * 2048 + k * 1024); } while (0)
#define PG8_LDB(dst, b, h) do { _Pragma("unroll") for (int n = 0; n < 2; ++n) _Pragma("unroll") for (int k = 0; k < 2; ++k) dst[n][k] = *(const PG8_LAS bf16x8*)(lds + PG8_SB(b, h) + boff + n * 2048 + k * 1024); } while (0)
#define PG8_MMA(ai, bj, At, Bt) do { __builtin_amdgcn_s_setprio(1); _Pragma("unroll") for (int m = 0; m < 4; ++m) _Pragma("unroll") for (int n = 0; n < 2; ++n) _Pragma("unroll") for (int k = 0; k < 2; ++k) \
        acc[ai][bj][m][n] = __builtin_amdgcn_mfma_f32_16x16x32_bf16(Bt[n][k], At[m][k], acc[ai][bj][m][n], 0, 0, 0); __builtin_amdgcn_s_setprio(0); } while (0)
#define PG8_WAIT_V(n) asm volatile("s_waitcnt vmcnt(" #n ")" ::: "memory")
#define PG8_WAIT_L(n) asm volatile("s_waitcnt lgkmcnt(" #n ")" ::: "memory")
#define PG8_BAR __builtin_amdgcn_s_barrier()
#define PG8_SCHED __builtin_amdgcn_sched_barrier(0)
    Unit cur, nxt; int ui = 0;
    if (!S.next(0, cur)) return;
    f32x4 acc[2][2][4][2];
#pragma unroll
    for (int a = 0; a < 2; ++a)
#pragma unroll
        for (int b = 0; b < 2; ++b)
#pragma unroll
            for (int m = 0; m < 4; ++m)
#pragma unroll
                for (int n = 0; n < 2; ++n) acc[a][b][m][n] = (f32x4){0.f, 0.f, 0.f, 0.f};
    bf16x8 At[4][2], B0[2][2], B1[2][2];
    const char* cA = (const char*)g.A + (size_t)cur.pm * tstep + cur.kh; const char* cB = (const char*)g.Bt + (size_t)cur.pn * tstep + cur.kh;
    S.a_ready(cur);
    PG8_STAGE(PG8_SB(0, 0), cB, voffB); PG8_STAGE(PG8_SA(0, 0), cA, voffA); PG8_STAGE(PG8_SB(0, 1), cB + hstep, voffB); PG8_STAGE(PG8_SA(0, 1), cA + hstep, voffA);
    if (wr == 1) PG8_BAR;
    PG8_WAIT_V(4); PG8_BAR;
    PG8_STAGE(PG8_SB(1, 0), cB + kstep, voffB); PG8_STAGE(PG8_SA(1, 0), cA + kstep, voffA); PG8_STAGE(PG8_SB(1, 1), cB + hstep + kstep, voffB);
    PG8_WAIT_V(6); PG8_BAR;
    for (;;) {
        const bool has_next = S.next(ui + 1, nxt);
        const char* nA = has_next ? (const char*)g.A + (size_t)nxt.pm * tstep + nxt.kh : cA; const char* nB = has_next ? (const char*)g.Bt + (size_t)nxt.pn * tstep + nxt.kh : cB;
        if constexpr (Epi::MIDK) {
            for (int t = 0; t < (nt >> 1); t += 2) PG8_KBODY
            E.mid(acc, cur, wr, wc, fr, fq);
            for (int t = (nt >> 1); t < nt; t += 2) PG8_KBODY
        } else {
            for (int t = 0; t < nt; t += 2) PG8_KBODY
        }
        if constexpr (!Epi::AFTER_DRAIN) { E(acc, cur, wr, wc, fr, fq); S.done(cur); }
        if (!has_next) break;
        if (!(Epi::KEEP && E.keep(cur))) {
#pragma unroll
        for (int a = 0; a < 2; ++a)
#pragma unroll
            for (int b = 0; b < 2; ++b)
#pragma unroll
                for (int m = 0; m < 4; ++m)
#pragma unroll
                    for (int n = 0; n < 2; ++n) acc[a][b][m][n] = (f32x4){0.f, 0.f, 0.f, 0.f};
        }
        cur = nxt; cA = nA; cB = nB; ++ui;
    }
    PG8_WAIT_V(0);
    if (wr == 0) PG8_BAR;
    PG8_BAR;
    if constexpr (Epi::AFTER_DRAIN) { E.fused(acc, cur, wr, wc, fr, fq, lds, wid, lane); S.done(cur); }
#undef PG8_KBODY
#undef PG8_SA
#undef PG8_SB
#undef PG8_STAGE
#undef PG8_LDA
#undef PG8_LDB
#undef PG8_MMA
#undef PG8_WAIT_V
#undef PG8_WAIT_L
#undef PG8_BAR
#undef PG8_SCHED
}
}
#define LAS PG8_LAS
#define XB_TMO      128
#define XB_XCNT(j)  (256  + 64 * (j))
#define XB_XSUB(j)  (1280 + 64 * (j))
#define XB_XGEN(j)  (2304 + 64 * (j))
#define XB_TOP      3328
#define XB_TOPGEN   3392
#define XCD_BAR_WORDS 3456
#define XB_SPIN_CAP (1u << 18)

__device__ __forceinline__ unsigned xb_ld(unsigned* p)              { return __hip_atomic_load(p, __ATOMIC_RELAXED, __HIP_MEMORY_SCOPE_AGENT); }
__device__ __forceinline__ unsigned xb_add(unsigned* p, unsigned v) { return __hip_atomic_fetch_add(p, v, __ATOMIC_RELAXED, __HIP_MEMORY_SCOPE_AGENT); }
__device__ __forceinline__ unsigned xb_xcc_id() { return (unsigned)__builtin_amdgcn_s_getreg((3 << 11) | 20) & 0xFu; }
#define XB_SPIN(cond, bar) do { unsigned _sp = 0; while (cond) { __builtin_amdgcn_s_sleep(1); \
    if ((++_sp & 255u) == 0u) { if (xb_ld(&(bar)[XB_TMO])) break; if (_sp > XB_SPIN_CAP) { atomicAdd(&(bar)[XB_TMO], 1u); break; } } } } while (0)

struct XcdBarrier {
    unsigned* bar; unsigned x;
    volatile LAS unsigned* st;
};

__device__ __forceinline__ XcdBarrier xcd_barrier_post(unsigned* bar, volatile LAS unsigned* st) {
    XcdBarrier b; b.bar = bar; b.x = xb_xcc_id(); b.st = st;
    if (threadIdx.x == 0) (void)xb_add(&bar[XB_XCNT(b.x)], 1u);
    return b;
}
__device__ __forceinline__ void xcd_barrier_complete(unsigned* bar, unsigned x, unsigned& nloc, unsigned& nx) {
    const unsigned G = gridDim.x * gridDim.y * gridDim.z;
    unsigned sum, cnt, mine, sp = 0u;
    for (;;) {
        sum = 0u; cnt = 0u; mine = 0u;
#pragma unroll
        for (unsigned j = 0; j < 16; ++j) { const unsigned c = xb_ld(&bar[XB_XCNT(j)]); sum += c; cnt += (c > 0u) ? 1u : 0u; mine = (j == x) ? c : mine; }
        if (sum == G) break;
        __builtin_amdgcn_s_sleep(1);
        if ((++sp & 255u) == 0u) { if (xb_ld(&bar[XB_TMO])) break; if (sp > XB_SPIN_CAP) { atomicAdd(&bar[XB_TMO], 1u); break; } }
    }
    nloc = mine > 0u ? mine : 1u; nx = cnt > 0u ? cnt : 1u;
}

__device__ __forceinline__ void xcd_barrier(const XcdBarrier& b) {
    asm volatile("s_waitcnt vmcnt(0)" ::: "memory");
    __syncthreads();
    if (threadIdx.x == 0) {
        unsigned* bar = b.bar;
        __builtin_amdgcn_s_waitcnt(0);
        unsigned nloc = b.st[0], nx = b.st[1];
        if (nloc == 0u) { xcd_barrier_complete(bar, b.x, nloc, nx); b.st[0] = nloc; b.st[1] = nx; }
        const unsigned old = xb_add(&bar[XB_XSUB(b.x)], 1u);
        const unsigned gen = old / nloc;
        if (old + 1u == (gen + 1u) * nloc) {
            __builtin_amdgcn_fence(__ATOMIC_RELEASE, "agent");
            asm volatile("s_waitcnt vmcnt(0)" ::: "memory");
            const unsigned og = xb_add(&bar[XB_TOP], 1u);
            const unsigned tg = og / nx;
            if (og + 1u == (tg + 1u) * nx) xb_add(&bar[XB_TOPGEN], 1u);
            else XB_SPIN(xb_ld(&bar[XB_TOPGEN]) == tg, bar);
            __builtin_amdgcn_fence(__ATOMIC_ACQUIRE, "agent");
            xb_add(&bar[XB_XGEN(b.x)], 1u);
            asm volatile("s_waitcnt vmcnt(0)" ::: "memory");
        } else {
            XB_SPIN(xb_ld(&bar[XB_XGEN(b.x)]) == gen, bar);
            __builtin_amdgcn_fence(__ATOMIC_ACQUIRE, "agent");
            asm volatile("s_waitcnt vmcnt(0)" ::: "memory");
        }
    }
    __syncthreads();
}

using namespace pg8;
#define BID ((int)__builtin_amdgcn_readfirstlane((int)blockIdx.x))
#define LAS PG8_LAS
typedef unsigned u32x2 __attribute__((ext_vector_type(2)));

constexpr int D = 1024, NB = 8, SEQ = 2048, MPR = NB * SEQ, MS = 128, MT = MPR + MS, MPAD = 16640;
constexpr int DIN = 4608, NMOD = 3072, NROWC = 136, KS_MOD = 8;
constexpr int NCG = 36, ZBLK = 16384;
constexpr int OFF_A = 0, OFF_GA = 512, OFF_U = 1024, OFF_V = 1536, OFF_GB = 2048, OFF_MA = 2560, OFF_MB = 3584;
constexpr size_t O_YP = 0, O_YS = 16777216, O_PP = 16908288, O_PS = 16969728, O_VP = 17952768, O_VS = 18477056;
constexpr size_t WS_MODP = 0;
constexpr size_t WS_GATE = WS_MODP + 13369344;
constexpr size_t WS_HB = WS_GATE + 557056;
constexpr size_t WS_WIN = WS_HB + 34078720;
constexpr size_t WS_WAB = WS_WIN + 9437184;
constexpr size_t WS_WO = WS_WAB + 2097152;
constexpr size_t WS_PW = WS_WO + 2097152;
constexpr size_t WS_SW = WS_PW + 131072;
constexpr size_t WS_Z = WS_SW + 131072;
constexpr size_t WS_YAB = WS_Z + 153354240;
constexpr size_t WS_RP = WS_YAB + 34078720;
constexpr size_t WS_XS = WS_RP + 1048576;
constexpr size_t WS_STATS = WS_XS + 524288;
constexpr size_t WS_PRESUM = WS_STATS + 133120;
constexpr size_t WS_BAR = WS_PRESUM + 262144;
constexpr size_t WS_END = WS_BAR + 16384;
constexpr int LDS_BAR_OFF = 131072, LDS_BYTES = 131072 + 64;
constexpr int NTHR = 512;

struct Args { const float* in[20]; float* out; unsigned char* ws; };

__device__ __forceinline__ unsigned pk_bf16(float lo, float hi) { unsigned r; asm("v_cvt_pk_bf16_f32 %0, %1, %2" : "=v"(r) : "v"(lo), "v"(hi)); return r; }
__device__ __forceinline__ float bf_lo(unsigned u) { return __uint_as_float(u << 16); }
__device__ __forceinline__ float bf_hi(unsigned u) { return __uint_as_float(u & 0xffff0000u); }
__device__ __forceinline__ float sigmoid_f(float x) { return __builtin_amdgcn_rcpf(1.0f + __expf(-x)); }
__device__ __forceinline__ float silu_f(float x) { return x * sigmoid_f(x); }
__device__ __forceinline__ float wave_sum(float v) {
    v += __shfl_xor(v, 1); v += __shfl_xor(v, 2); v += __shfl_xor(v, 4); v += __shfl_xor(v, 8); v += __shfl_xor(v, 16); v += __shfl_xor(v, 32); return v;
}
__device__ __forceinline__ f32x4 act4(f32x4 v, int act) {
    if (act == 1) { v[0] = silu_f(v[0]); v[1] = silu_f(v[1]); v[2] = silu_f(v[2]); v[3] = silu_f(v[3]); }
    else if (act == 2) { const f32x2 a = gelu_pk((f32x2){v[0], v[1]}), b = gelu_pk((f32x2){v[2], v[3]}); v = (f32x4){a.x, a.y, b.x, b.y}; }
    else if (act == 3) { v[0] = sigmoid_f(v[0]); v[1] = sigmoid_f(v[1]); v[2] = sigmoid_f(v[2]); v[3] = sigmoid_f(v[3]); }
    return v;
}

struct EpiZ {
    static constexpr bool PERM = true, AFTER_DRAIN = false, MIDK = false, KEEP = false;
    __device__ __forceinline__ bool keep(const Unit&) const { return false; }
    bf16_t* Z; float* stats;
    __device__ __forceinline__ void mid(f32x4 (&)[2][2][4][2], const Unit&, int, int, int, int) const {}
    __device__ __forceinline__ void fused(f32x4 (&)[2][2][4][2], const Unit&, int, int, int, int, LAS unsigned char*, int, int) const {}
    __device__ __forceinline__ void operator()(const f32x4 (&acc)[2][2][4][2], const Unit& u, int wr, int wc, int fr, int fq) const {
        int t_ = threadIdx.x; asm volatile("" : "+v"(t_));
        { const int wid_ = __builtin_amdgcn_readfirstlane(t_ >> 6), lane_ = t_ & 63; wr = wid_ >> 2; wc = wid_ & 3; fr = lane_ & 15; fq = lane_ >> 4; }
        const int pn = u.pn;
        const int act = pn < 2 ? 0 : pn < 4 ? 1 : pn < 8 ? 4 : pn < 10 ? 2 : 3;
        const bool isv = (pn == 8) || (pn == 9);
        const int cg0 = (pn >= 4 && pn < 8) ? 4 + pn : (pn == 8 || pn == 9) ? pn + 4 + (pn - 8) : pn * 2;
#pragma unroll
        for (int ai = 0; ai < 2; ++ai) {
            const int rt = u.pm * 2 + ai;
            if (rt * 128 < MT) {
                bf16_t* blk = Z + ((size_t)rt * NCG + cg0) * ZBLK + wc * 32 + 8 * fq;
#pragma unroll
                for (int m = 0; m < 4; ++m) {
                    const int r = wr * 64 + m * 16 + fr;
                    bf16_t* rowp = blk + r * 128;
                    if (act == 3) {
                        f32x4 rr[2], sb[2];
#pragma unroll
                        for (int n = 0; n < 2; ++n)
#pragma unroll
                            for (int j = 0; j < 4; ++j) { const float eb = 1.0f + fminf(__expf(-acc[ai][1][m][n][j]), 1e6f), ea = 1.0f + __expf(-acc[ai][0][m][n][j]); sb[n][j] = __builtin_amdgcn_rcpf(eb); rr[n][j] = eb * __builtin_amdgcn_rcpf(ea); }
                        u32x4 w; w.x = pk_bf16(rr[0][0], rr[0][1]); w.y = pk_bf16(rr[0][2], rr[0][3]); w.z = pk_bf16(rr[1][0], rr[1][1]); w.w = pk_bf16(rr[1][2], rr[1][3]);
                        *(u32x4*)(rowp) = w;
                        w.x = pk_bf16(sb[0][0], sb[0][1]); w.y = pk_bf16(sb[0][2], sb[0][3]); w.z = pk_bf16(sb[1][0], sb[1][1]); w.w = pk_bf16(sb[1][2], sb[1][3]);
                        *(u32x4*)(rowp + ZBLK) = w;
                    } else if (act == 4) {
                        const f32x4 u0 = act4(acc[ai][0][m][0], 2), u1 = act4(acc[ai][0][m][1], 2), g0 = act4(acc[ai][1][m][0], 1), g1 = act4(acc[ai][1][m][1], 1);
                        const f32x4 p0 = u0 * g0, p1 = u1 * g1;
                        u32x4 w; w.x = pk_bf16(p0[0], p0[1]); w.y = pk_bf16(p0[2], p0[3]); w.z = pk_bf16(p1[0], p1[1]); w.w = pk_bf16(p1[2], p1[3]);
                        *(u32x4*)(rowp) = w;
                    } else {
                        float ssum = 0.f, ssq = 0.f;
#pragma unroll
                        for (int bj = 0; bj < 2; ++bj) {
                            const f32x4 v0 = act4(acc[ai][bj][m][0], act), v1 = act4(acc[ai][bj][m][1], act);
                            u32x4 w; w.x = pk_bf16(v0[0], v0[1]); w.y = pk_bf16(v0[2], v0[3]); w.z = pk_bf16(v1[0], v1[1]); w.w = pk_bf16(v1[2], v1[3]);
                            *(u32x4*)(rowp + bj * ZBLK) = w;
                            if (isv) {
                                ssum += (v0[0] + v0[1]) + (v0[2] + v0[3]) + (v1[0] + v1[1]) + (v1[2] + v1[3]);
                                ssq += (v0[0] * v0[0] + v0[1] * v0[1]) + (v0[2] * v0[2] + v0[3] * v0[3]) + (v1[0] * v1[0] + v1[1] * v1[1]) + (v1[2] * v1[2] + v1[3] * v1[3]);
                            }
                        }
                        if (isv) {
                            ssum += __shfl_xor(ssum, 16); ssum += __shfl_xor(ssum, 32); ssq += __shfl_xor(ssq, 16); ssq += __shfl_xor(ssq, 32);
                            if (fq == 0) {
                                float* sp = stats + (size_t)(rt * 128 + r) * 2;
                                __hip_atomic_fetch_add(sp, ssum, __ATOMIC_RELAXED, __HIP_MEMORY_SCOPE_AGENT);
                                __hip_atomic_fetch_add(sp + 1, ssq, __ATOMIC_RELAXED, __HIP_MEMORY_SCOPE_AGENT);
                            }
                        }
                    }
                }
            }
        }
    }
};

struct EpiMerged {
    static constexpr bool PERM = true, AFTER_DRAIN = false, MIDK = false, KEEP = true;
    const bf16_t* Z; bf16_t* O;
    __device__ __forceinline__ bool keep(const Unit& u) const { return u.kh == 0; }
    __device__ __forceinline__ void mid(f32x4 (&)[2][2][4][2], const Unit&, int, int, int, int) const {}
    __device__ __forceinline__ void fused(f32x4 (&)[2][2][4][2], const Unit&, int, int, int, int, LAS unsigned char*, int, int) const {}
    __device__ __forceinline__ void operator()(f32x4 (&acc)[2][2][4][2], const Unit& u, int wr, int wc, int fr, int fq) const {
        const char* zb = (const char*)Z;
        const bool first = u.kh == 0;
        const unsigned off0 = (((unsigned)(u.pm * 2) * NCG + (first ? 20 : 21) + 4 * u.pn) * ZBLK + (wr * 64 + fr) * 128 + wc * 32 + 8 * fq) * 2u;
        const int row0 = u.pm * BM + wr * 64 + fr, col0 = u.pn * BM + wc * 32 + 8 * fq;
#pragma unroll
        for (int ai = 0; ai < 2; ++ai) {
            u32x4 r[4][2];
#pragma unroll
            for (int m = 0; m < 4; ++m)
#pragma unroll
                for (int bj = 0; bj < 2; ++bj) r[m][bj] = *(const u32x4*)(zb + off0 + (unsigned)((ai * NCG + 2 * bj) * ZBLK + m * 16 * 128) * 2u);
#pragma unroll
            for (int m = 0; m < 4; ++m)
#pragma unroll
                for (int bj = 0; bj < 2; ++bj) {
                    const u32x4 a = r[m][bj];
                    const f32x4 v0 = acc[ai][bj][m][0] * (f32x4){bf_lo(a.x), bf_hi(a.x), bf_lo(a.y), bf_hi(a.y)};
                    const f32x4 v1 = acc[ai][bj][m][1] * (f32x4){bf_lo(a.z), bf_hi(a.z), bf_lo(a.w), bf_hi(a.w)};
                    if (first) { acc[ai][bj][m][0] = v0; acc[ai][bj][m][1] = v1; }
                    else {
                        u32x4 w; w.x = pk_bf16(v0[0], v0[1]); w.y = pk_bf16(v0[2], v0[3]); w.z = pk_bf16(v1[0], v1[1]); w.w = pk_bf16(v1[2], v1[3]);
                        *(u32x4*)(O + (size_t)(row0 + ai * HALF + m * 16) * D + col0 + bj * HALF) = w;
                    }
                }
        }
    }
};

struct EpiFinal {
    static constexpr bool PERM = false, AFTER_DRAIN = true, MIDK = false, KEEP = false;
    __device__ __forceinline__ bool keep(const Unit&) const { return false; }
    const float* x; const float* gate; const float* fgain; float* rp; float* y; const float* xs; float* ys; unsigned* barw;
    __device__ __forceinline__ void mid(f32x4 (&)[2][2][4][2], const Unit&, int, int, int, int) const {}
    __device__ __forceinline__ void operator()(const f32x4 (&)[2][2][4][2], const Unit&, int, int, int, int) const {}
    __device__ __forceinline__ void fused(f32x4 (&acc)[2][2][4][2], const Unit& u, int wr, int wc, int fr, int fq, LAS unsigned char* lds, int wid, int lane) const {
        int t_ = threadIdx.x; asm volatile("" : "+v"(t_));
        { const int wid_ = __builtin_amdgcn_readfirstlane(t_ >> 6), lane_ = t_ & 63; wr = wid_ >> 2; wc = wid_ & 3; fr = lane_ & 15; fq = lane_ >> 4; }
        wid = t_ >> 6; lane = t_ & 63;
        const int col0 = u.pn * BM + wc * 32 + 4 * fq, b = u.pm >> 3;
        {
            f32x4 g[2][2];
#pragma unroll
            for (int bj = 0; bj < 2; ++bj)
#pragma unroll
                for (int n = 0; n < 2; ++n) g[bj][n] = *(const f32x4*)(gate + b * D + col0 + bj * HALF + n * 16);
#pragma unroll
            for (int ai = 0; ai < 2; ++ai)
#pragma unroll
                for (int m = 0; m < 4; ++m) {
                    const int row = u.pm * BM + ai * HALF + wr * 64 + m * 16 + fr;
                    const float* xr = x + (size_t)row * D + col0;
                    float ss = 0.f;
#pragma unroll
                    for (int bj = 0; bj < 2; ++bj)
#pragma unroll
                        for (int n = 0; n < 2; ++n) {
                            const f32x4 xv = *(const f32x4*)(xr + bj * HALF + n * 16);
                            const f32x4 v = xv + g[bj][n] * acc[ai][bj][m][n];
                            acc[ai][bj][m][n] = v;
                            ss += (v[0] * v[0] + v[1] * v[1]) + (v[2] * v[2] + v[3] * v[3]);
                        }
                    ss += __shfl_xor(ss, 16); ss += __shfl_xor(ss, 32);
                    if (fq == 0) rp[(size_t)row * 16 + u.pn * 4 + wc] = ss;
                    if (m == 3) asm volatile("" ::: "memory");
                }
        }
        { XcdBarrier b_; b_.bar = barw; b_.x = xb_xcc_id(); b_.st = (volatile LAS unsigned*)(lds + LDS_BAR_OFF); xcd_barrier(b_); }
        {
            f32x4 fg[2][2];
#pragma unroll
            for (int bj = 0; bj < 2; ++bj)
#pragma unroll
                for (int n = 0; n < 2; ++n) fg[bj][n] = *(const f32x4*)(fgain + col0 + bj * HALF + n * 16);
#pragma unroll
            for (int ai = 0; ai < 2; ++ai)
#pragma unroll
                for (int m = 0; m < 4; ++m) {
                    const int row = u.pm * BM + ai * HALF + wr * 64 + m * 16 + fr;
                    const f32x4* p = (const f32x4*)(rp + (size_t)row * 16);
                    const f32x4 p0 = p[0], p1 = p[1], p2 = p[2], p3 = p[3];
                    const f32x4 ps = (p0 + p1) + (p2 + p3);
                    const float tot = (ps[0] + ps[1]) + (ps[2] + ps[3]);
                    const float r = rsqrtf(tot * (1.0f / 1024.0f) + 1e-6f);
                    float* yr = y + (size_t)row * D + col0;
#pragma unroll
                    for (int bj = 0; bj < 2; ++bj)
#pragma unroll
                        for (int n = 0; n < 2; ++n) *(f32x4*)(yr + bj * HALF + n * 16) = acc[ai][bj][m][n] * r * fg[bj][n];
                }
        }
        const int srow = BID * 8 + wid;
        if (srow < MS) {
            f32x4 v[4]; float ss = 0.f;
#pragma unroll
            for (int q = 0; q < 4; ++q) { v[q] = *(const f32x4*)(xs + (size_t)srow * D + lane * 4 + 256 * q); ss += (v[q][0] * v[q][0] + v[q][1] * v[q][1]) + (v[q][2] * v[q][2] + v[q][3] * v[q][3]); }
            ss = wave_sum(ss);
            const float r = rsqrtf(ss * (1.0f / 1024.0f) + 1e-6f);
#pragma unroll
            for (int q = 0; q < 4; ++q) { const f32x4 fgv = *(const f32x4*)(fgain + lane * 4 + 256 * q); *(f32x4*)(ys + (size_t)srow * D + lane * 4 + 256 * q) = v[q] * r * fgv; }
        }
    }
};

constexpr int N_ORDER_B = 146;
struct OrderAB {
    int c, stage;
    __device__ __forceinline__ bool next(int i, Unit& u) const {
        if (stage == 0) {
            if (i >= 4) return false;
            const int j = i * 32 + (c >> 3); int pm = 8 * (c & 7) + (j & 7), pn = j >> 3;
            if (pn == 15 && pm < 10) { pn = pm; pm = 64; }
            u.pm = pm; u.pn = pn; return true;
        }
        if (i > 0 || c >= N_ORDER_B) return false;
        if (c < 128) { u.pm = c >> 1; u.pn = 16 + (c & 1); } else if (c < 136) { u.pm = 64; u.pn = 10 + (c - 128); } else { u.pm = c - 136; u.pn = 15; }
        return true;
    }
    __device__ __forceinline__ void a_ready(const Unit&) const {}
    __device__ __forceinline__ void done(const Unit&) const {}
};

struct OrderK2 {
    StaticOrder so;
    __device__ __forceinline__ bool next(int i, Unit& u) const { if (i >= 2) return false; if (!so.next(0, u)) return false; u.kh = i * 1024; return true; }
    __device__ __forceinline__ void a_ready(const Unit&) const {}
    __device__ __forceinline__ void done(const Unit&) const {}
};

__device__ __forceinline__ void transpose_tile(LAS unsigned char* lds, const float* src, int ldsrc, bf16_t* dst, int ldd, int k0, int n0) {
    LAS float* t = (LAS float*)lds;
    const int tid = threadIdx.x;
    {
        f32x4 v[4];
#pragma unroll
        for (int i = 0; i < 4; ++i) { const int idx = tid + NTHR * i, k = idx >> 4, n4 = (idx & 15) * 4; v[i] = *(const f32x4*)(src + (size_t)(k0 + k) * ldsrc + n0 + n4); }
#pragma unroll
        for (int i = 0; i < 4; ++i) { const int idx = tid + NTHR * i, k = idx >> 4, n4 = (idx & 15) * 4; LAS float* d = t + k * 65 + n4; d[0] = v[i][0]; d[1] = v[i][1]; d[2] = v[i][2]; d[3] = v[i][3]; }
    }
    __syncthreads();
#pragma unroll
    for (int i = 0; i < 2; ++i) {
        const int idx = tid + NTHR * i, n = idx >> 4, kc = (idx & 15) * 8;
        const LAS float* s = t + kc * 65 + n;
        u32x4 w;
        w.x = pk_bf16(s[0 * 65], s[1 * 65]); w.y = pk_bf16(s[2 * 65], s[3 * 65]); w.z = pk_bf16(s[4 * 65], s[5 * 65]); w.w = pk_bf16(s[6 * 65], s[7 * 65]);
        *(u32x4*)(dst + (size_t)(n0 + n) * ldd + k0 + kc) = w;
    }
    __syncthreads();
}

__device__ __forceinline__ void p0_phase(const Args& a, LAS unsigned char* lds) {
    int tid_ = threadIdx.x; asm volatile("" : "+v"(tid_));
    const int tid = tid_, wid = tid >> 6, lane = tid & 63, fr = lane & 15, fq = lane >> 4;
    unsigned char* ws = a.ws;
    for (int i = tid; i < 130; i += NTHR) ((float*)(ws + WS_STATS))[BID * 130 + i] = 0.f;
    if (tid < 64) {
        const int task = BID * 64 + tid, r = task >> 7, c4 = (task & 127) * 4, w = 2 << (c4 >> 7);
        const float* sp = a.in[2] + (size_t)r * 15 * 512 + c4;
        float* o = a.out + O_PS + (size_t)r * 15 * 512 + c4;
        f32x4 pv[15];
#pragma unroll
        for (int i = 0; i < 15; ++i) pv[i] = *(const f32x4*)(sp + i * 512);
        f32x4 ps = (f32x4){0.f, 0.f, 0.f, 0.f};
#pragma unroll
        for (int i = 0; i < 15; ++i) { if (15 - i <= w - 1) ps += pv[i]; if (i >= 1) *(f32x4*)(o + (i - 1) * 512) = pv[i]; }
        *(f32x4*)((float*)(ws + WS_PRESUM) + (size_t)r * 512 + c4) = ps;
    }
    constexpr int N_MOD = 24 * KS_MOD, N_WIN = 8 * 72, N_WAB = 128, N_WO = 128, N_PW = 8, N_SW = 16;
    constexpr int I_WIN = N_MOD, I_WAB = I_WIN + N_WIN, I_WO = I_WAB + N_WAB, I_PW = I_WO + N_WO, I_SW = I_PW + N_PW, I_END = I_SW + N_SW;
    for (int item = BID; item < I_END; item += gridDim.x) {
        if (item < N_MOD) {
            const int ks = item / 24, ng = item % 24, k0 = ks * 128, n0 = ng * 128 + wid * 16;
            LAS bf16_t* As = (LAS bf16_t*)lds;
            float bw[4][8];
#pragma unroll
            for (int q = 0; q < 4; ++q)
#pragma unroll
                for (int j = 0; j < 8; ++j) bw[q][j] = a.in[5][(size_t)(k0 + q * 32 + fq * 8 + j) * NMOD + n0 + fr];
            {
                f32x4 clo[5], chi[5];
#pragma unroll
                for (int i = 0; i < 5; ++i) {
                    const int p = tid + NTHR * i, r = p >> 4, c8 = (p & 15) * 8;
                    clo[i] = (f32x4){0.f, 0.f, 0.f, 0.f}; chi[i] = clo[i];
                    if (r < NROWC) { const float* cp = (r < NB ? a.in[3] + r * D : a.in[4] + (r - NB) * D) + k0 + c8; clo[i] = *(const f32x4*)cp; chi[i] = *(const f32x4*)(cp + 4); }
                }
#pragma unroll
                for (int i = 0; i < 5; ++i) {
                    const int p = tid + NTHR * i, r = p >> 4, c8 = (p & 15) * 8;
                    if (p < 144 * 16) {
                        u32x4 w = (u32x4){0u, 0u, 0u, 0u};
                        if (r < NROWC) { const f32x4 lo = clo[i], hi = chi[i];
                            w.x = pk_bf16(silu_f(lo[0]), silu_f(lo[1])); w.y = pk_bf16(silu_f(lo[2]), silu_f(lo[3])); w.z = pk_bf16(silu_f(hi[0]), silu_f(hi[1])); w.w = pk_bf16(silu_f(hi[2]), silu_f(hi[3])); }
                        *(LAS u32x4*)(As + r * 136 + c8) = w;
                    }
                }
            }
            __syncthreads();
            bf16x8 bfr[4];
#pragma unroll
            for (int q = 0; q < 4; ++q) {
                u32x4 w; w.x = pk_bf16(bw[q][0], bw[q][1]); w.y = pk_bf16(bw[q][2], bw[q][3]); w.z = pk_bf16(bw[q][4], bw[q][5]); w.w = pk_bf16(bw[q][6], bw[q][7]);
                bfr[q] = __builtin_bit_cast(bf16x8, w);
            }
            float* mp = (float*)(ws + WS_MODP) + (size_t)ks * NROWC * NMOD + n0 + fr;
#pragma unroll
            for (int rt = 0; rt < 9; ++rt) {
                f32x4 acc = (f32x4){0.f, 0.f, 0.f, 0.f};
#pragma unroll
                for (int q = 0; q < 4; ++q) {
                    const bf16x8 af = *(const LAS bf16x8*)(As + (rt * 16 + fr) * 136 + q * 32 + fq * 8);
                    acc = __builtin_amdgcn_mfma_f32_16x16x32_bf16(af, bfr[q], acc, 0, 0, 0);
                }
#pragma unroll
                for (int r = 0; r < 4; ++r) { const int row = rt * 16 + fq * 4 + r; if (row < NROWC) mp[(size_t)row * NMOD] = acc[r]; }
            }
            __syncthreads();
        } else if (item < I_WAB) {
            const int i = item - I_WIN, kt = i & 7, nt = i >> 3;
            int nsrc = nt * 64;
            if (nsrc >= OFF_MA) { const int q = nsrc - OFF_MA, j = q >> 8, wi = q & 255; nsrc = ((wi >> 7) ? OFF_MB : OFF_MA) + j * 128 + (wi & 127); }
            else if (nsrc >= 2048) nsrc = OFF_V + (nsrc - 2048);
            else if (nsrc >= 1024) { const int q = nsrc - 1024, g = q >> 8, wi = q & 255; nsrc = ((wi >> 7) ? OFF_GB : OFF_U) + g * 128 + (wi & 127); }
            transpose_tile(lds, a.in[8] + nsrc, DIN, (bf16_t*)(ws + WS_WIN) + (size_t)(nt * 64) * D, D, kt * 128, 0);
        } else if (item < I_WO) {
            const int i = item - I_WAB, half = i >> 6, j = i & 63, kt = j & 3, nt = j >> 2;
            transpose_tile(lds, half ? a.in[17] : a.in[16], D, (bf16_t*)(ws + WS_WAB) + half * 512, D, kt * 128, nt * 64);
        } else if (item < I_PW) {
            const int i = item - I_WO, kt = i & 7, nt = i >> 3;
            transpose_tile(lds, a.in[18], D, (bf16_t*)(ws + WS_WO), D, kt * 128, nt * 64);
        } else if (item < I_SW) {
            const int i = item - I_PW, g = i >> 1, nt = i & 1;
            transpose_tile(lds, a.in[9] + g * 16384, 128, (bf16_t*)(ws + WS_PW) + g * 16384, 128, 0, nt * 64);
        } else {
            const int i = item - I_SW, idx = i * 4096 + tid * 8, t = (idx >> 7) & 127, s0 = idx & 127;
            const f32x4 v0 = *(const f32x4*)(a.in[14] + idx), v1 = *(const f32x4*)(a.in[14] + idx + 4);
            u32x4 w;
            w.x = pk_bf16(s0 + 0 <= t ? v0[0] : 0.f, s0 + 1 <= t ? v0[1] : 0.f); w.y = pk_bf16(s0 + 2 <= t ? v0[2] : 0.f, s0 + 3 <= t ? v0[3] : 0.f);
            w.z = pk_bf16(s0 + 4 <= t ? v1[0] : 0.f, s0 + 5 <= t ? v1[1] : 0.f); w.w = pk_bf16(s0 + 6 <= t ? v1[2] : 0.f, s0 + 7 <= t ? v1[3] : 0.f);
            *(u32x4*)((bf16_t*)(ws + WS_SW) + idx) = w;
        }
    }
}

__device__ __forceinline__ void h_row(const float* xr, bf16_t* hr, const f32x4 (&s1)[4], const f32x4 (&s0)[4], int lane) {
    f32x4 v[4]; float ss = 0.f;
#pragma unroll
    for (int q = 0; q < 4; ++q) { v[q] = *(const f32x4*)(xr + lane * 4 + 256 * q); ss += (v[q][0] * v[q][0] + v[q][1] * v[q][1]) + (v[q][2] * v[q][2] + v[q][3] * v[q][3]); }
    ss = wave_sum(ss);
    const float r = rsqrtf(ss * (1.0f / 1024.0f) + 1e-6f);
#pragma unroll
    for (int q = 0; q < 4; ++q) {
        const f32x4 h = (v[q] * r) * s1[q] + s0[q];
        u32x2 w; w.x = pk_bf16(h[0], h[1]); w.y = pk_bf16(h[2], h[3]);
        *(u32x2*)(hr + lane * 4 + 256 * q) = w;
    }
}

__device__ __forceinline__ void p1_load(const Args& a, f32x4 (&xv)[8][4], float (&xr)[8]) {
    int tid_ = threadIdx.x; asm volatile("" : "+v"(tid_));
    const int tid = tid_, wid = tid >> 6, lane = tid & 63;
    const float* xb = a.in[0] + (size_t)(BID * 64 + wid * 8) * D + lane * 4;
#pragma unroll
    for (int j = 0; j < 8; ++j)
#pragma unroll
        for (int q = 0; q < 4; ++q) xv[j][q] = *(const f32x4*)(xb + (size_t)j * D + 256 * q);
#pragma unroll
    for (int j = 0; j < 8; ++j) {
        float ss = 0.f;
#pragma unroll
        for (int q = 0; q < 4; ++q) ss += (xv[j][q][0] * xv[j][q][0] + xv[j][q][1] * xv[j][q][1]) + (xv[j][q][2] * xv[j][q][2] + xv[j][q][3] * xv[j][q][3]);
        ss = wave_sum(ss);
        xr[j] = rsqrtf(ss * (1.0f / 1024.0f) + 1e-6f);
    }
}

__device__ __forceinline__ void p1_phase(const Args& a, LAS unsigned char* lds, const f32x4 (&xv)[8][4], const float (&xr)[8]) {
    int tid_ = threadIdx.x; asm volatile("" : "+v"(tid_));
    const int tid = tid_, wid = tid >> 6, lane = tid & 63;
    unsigned char* ws = a.ws;
    const float* modp = (const float*)(ws + WS_MODP);
    const float* b_ada = a.in[6]; const float* ngain = a.in[7];
    bf16_t* hb = (bf16_t*)(ws + WS_HB);
    LAS float* S1 = (LAS float*)lds; LAS float* S0 = S1 + 1024;
    {
        const int blk = BID, b = blk >> 5;
        __syncthreads();
        for (int n = tid; n < D; n += NTHR) {
            float sh = b_ada[n], sc = b_ada[D + n];
#pragma unroll
            for (int ks = 0; ks < KS_MOD; ++ks) { sh += modp[((size_t)ks * NROWC + b) * NMOD + n]; sc += modp[((size_t)ks * NROWC + b) * NMOD + D + n]; }
            S1[n] = (1.0f + sc) * ngain[n]; S0[n] = sh;
        }
        __syncthreads();
        f32x4 s1[4], s0[4];
#pragma unroll
        for (int q = 0; q < 4; ++q) { s1[q] = *(const LAS f32x4*)(S1 + lane * 4 + 256 * q); s0[q] = *(const LAS f32x4*)(S0 + lane * 4 + 256 * q); }
        bf16_t* hr = hb + (size_t)(blk * 64 + wid * 8) * D + lane * 4;
#pragma unroll
        for (int j = 0; j < 8; ++j)
#pragma unroll
            for (int q = 0; q < 4; ++q) {
                const f32x4 h = (xv[j][q] * xr[j]) * s1[q] + s0[q];
                u32x2 w; w.x = pk_bf16(h[0], h[1]); w.y = pk_bf16(h[2], h[3]);
                *(u32x2*)(hr + (size_t)j * D + 256 * q) = w;
            }
    }
    for (int j = BID * 8 + wid; j < MS; j += (int)gridDim.x * 8) {
        f32x4 s1[4], s0[4];
#pragma unroll
        for (int q = 0; q < 4; ++q) {
            const int n = lane * 4 + 256 * q;
            f32x4 sh = *(const f32x4*)(b_ada + n), sc = *(const f32x4*)(b_ada + D + n);
#pragma unroll
            for (int ks = 0; ks < KS_MOD; ++ks) {
                sh += *(const f32x4*)(modp + ((size_t)ks * NROWC + NB + j) * NMOD + n);
                sc += *(const f32x4*)(modp + ((size_t)ks * NROWC + NB + j) * NMOD + D + n);
            }
            s1[q] = (sc + 1.0f) * *(const f32x4*)(ngain + n); s0[q] = sh;
        }
        h_row(a.in[1] + (size_t)j * D, hb + (size_t)(MPR + j) * D, s1, s0, lane);
    }
    float* gate = (float*)(ws + WS_GATE);
    for (int r = BID; r < NROWC; r += gridDim.x)
        for (int n = tid; n < D; n += NTHR) {
            float g = b_ada[2 * D + n];
#pragma unroll
            for (int ks = 0; ks < KS_MOD; ++ks) g += modp[((size_t)ks * NROWC + r) * NMOD + 2 * D + n];
            gate[(size_t)r * D + n] = g;
        }
}

constexpr int LP = 136;
__device__ __forceinline__ void unpack8(const u32x4 v, f32x4& lo, f32x4& hi) {
    lo = (f32x4){bf_lo(v.x), bf_hi(v.x), bf_lo(v.y), bf_hi(v.y)}; hi = (f32x4){bf_lo(v.z), bf_hi(v.z), bf_lo(v.w), bf_hi(v.w)};
}
__device__ __forceinline__ u32x4 pack8(const f32x4 lo, const f32x4 hi) {
    u32x4 w; w.x = pk_bf16(lo[0], lo[1]); w.y = pk_bf16(lo[2], lo[3]); w.z = pk_bf16(hi[0], hi[1]); w.w = pk_bf16(hi[2], hi[3]); return w;
}

__device__ __forceinline__ void p3_phase(const Args& a, LAS unsigned char* lds, int item0, int item_end, int item_step) {
    unsigned char* ws = a.ws;
    const bf16_t* Z = (const bf16_t*)(ws + WS_Z);
    bf16_t* YAB = (bf16_t*)(ws + WS_YAB);
    const bf16_t* PW = (const bf16_t*)(ws + WS_PW);
    const bf16_t* SW = (const bf16_t*)(ws + WS_SW);
    const float* stats = (const float*)(ws + WS_STATS);
    float* out = a.out;
    LAS bf16_t* Xs = (LAS bf16_t*)lds;
    LAS bf16_t* Ys = (LAS bf16_t*)(lds + 34816);
    LAS bf16_t* Es = (LAS bf16_t*)(lds + 69632);
    for (int item = item0; item < item_end; item += item_step) {
        int tid_ = threadIdx.x; asm volatile("" : "+v"(tid_));
        const int tid = tid_, wid = tid >> 6, lane = tid & 63, fr = lane & 15, fq = lane >> 4, pr = tid >> 4, pc = tid & 15;
        const int tile = item < 8 ? 128 : (item >> 3) - 1, sub = ((item & 7) + (item >> 3)) & 7, g = sub & 3;
        const bool isB = sub >= 4, sample = tile == 128;
        const int row0 = tile * 128, b = tile >> 4, n = tile & 15;
        const int t = wid * 16 + fr;
        const size_t row = (size_t)(row0 + t);
        const bf16_t* zt = Z + (size_t)tile * NCG * ZBLK;
        u32x2 e0[8];
        __syncthreads();
        if (!isB) {
            const int w = 2 << g;
            u32x4 pwv[4];
#pragma unroll
            for (int i = 0; i < 4; ++i) { const int p = tid + NTHR * i; pwv[i] = *(const u32x4*)(PW + g * 16384 + p * 8); }
#pragma unroll
            for (int ct = 0; ct < 8; ++ct) e0[ct] = *(const u32x2*)(zt + (4 + g) * ZBLK + t * 128 + ct * 16 + fq * 4);
            if (!sample) {
                u32x4 ev[5];
#pragma unroll
                for (int i = 0; i < 5; ++i) {
                    const int p = tid + NTHR * i;
                    ev[i] = (u32x4){0u, 0u, 0u, 0u};
                    if (p < 16 * 16) { if (n > 0) ev[i] = *(const u32x4*)(zt - (size_t)NCG * ZBLK + g * ZBLK + (112 * 16 + p) * 8); }
                    else if (p < 144 * 16) ev[i] = *(const u32x4*)(zt + g * ZBLK + (p - 256) * 8);
                }
#pragma unroll
                for (int i = 0; i < 4; ++i) { const int p = tid + NTHR * i, r = p >> 4, c = p & 15; *(LAS u32x4*)(Xs + r * LP + ((c ^ ((r >> 3) & 15)) << 3)) = pwv[i]; }
#pragma unroll
                for (int i = 0; i < 5; ++i) { const int p = tid + NTHR * i, r = p >> 4, c = p & 15; if (p < 144 * 16) *(LAS u32x4*)(Es + r * LP + c * 8) = ev[i]; }
                __syncthreads();
                {
                    f32x4 s_lo = (f32x4){0.f, 0.f, 0.f, 0.f}, s_hi = s_lo;
                    for (int j = 1; j < w; ++j) {
                        f32x4 lo, hi; unpack8(*(const LAS u32x4*)(Es + (16 + pr * 4 - j) * LP + pc * 8), lo, hi);
                        s_lo += lo; s_hi += hi;
                    }
#pragma unroll 1
                    for (int i = 0; i < 4; ++i) {
                        const int tt = pr * 4 + i;
                        f32x4 a_lo, a_hi; unpack8(*(const LAS u32x4*)(Es + (16 + tt) * LP + pc * 8), a_lo, a_hi);
                        s_lo += a_lo; s_hi += a_hi;
                        const int cnt = min(n * 128 + tt + 1, w);
                        const float inv = 1.0f / (float)cnt;
                        *(LAS u32x4*)(Ys + tt * LP + pc * 8) = pack8(s_lo * inv - a_lo, s_hi * inv - a_hi);
                        if (n == 15 && tt >= 113) {
                            float* o = out + O_PP + ((size_t)(b * 15 + (tt - 113)) * 512 + g * 128 + pc * 8);
                            *(f32x4*)o = a_lo; *(f32x4*)(o + 4) = a_hi;
                        }
                        f32x4 d_lo, d_hi; unpack8(*(const LAS u32x4*)(Es + (16 + tt + 1 - w) * LP + pc * 8), d_lo, d_hi);
                        s_lo -= d_lo; s_hi -= d_hi;
                    }
                }
            } else {
#pragma unroll
                for (int i = 0; i < 4; ++i) { const int p = tid + NTHR * i, r = p >> 4, c = p & 15; *(LAS u32x4*)(Xs + r * LP + ((c ^ ((r >> 3) & 15)) << 3)) = pwv[i]; }
                const float* presum = (const float*)(ws + WS_PRESUM);
                const float inv = 1.0f / (float)w;
#pragma unroll 1
                for (int pass = 0; pass < 4; ++pass) {
                    const int r = pass * 32 + pr;
                    f32x4 a_lo, a_hi; unpack8(*(const u32x4*)(zt + g * ZBLK + r * 128 + pc * 8), a_lo, a_hi);
                    const f32x4 p_lo = *(const f32x4*)(presum + (size_t)r * 512 + g * 128 + pc * 8), p_hi = *(const f32x4*)(presum + (size_t)r * 512 + g * 128 + pc * 8 + 4);
                    float* o = out + O_PS + ((size_t)r * 15 + 14) * 512 + g * 128 + pc * 8;
                    *(f32x4*)o = a_lo; *(f32x4*)(o + 4) = a_hi;
                    *(LAS u32x4*)(Ys + r * LP + pc * 8) = pack8((a_lo + p_lo) * inv - a_lo, (a_hi + p_hi) * inv - a_hi);
                }
            }
            __syncthreads();
        } else {
            u32x4 vv[4]; f32x2 st[4];
#pragma unroll
            for (int i = 0; i < 4; ++i) { const int p = tid + NTHR * i; vv[i] = *(const u32x4*)(zt + (12 + g) * ZBLK + p * 8); st[i] = *(const f32x2*)(stats + (size_t)(row0 + (p >> 4)) * 2); }
            const int ch = g * 128 + pc * 8;
            const f32x4 lg0 = *(const f32x4*)(a.in[12] + ch), lg1 = *(const f32x4*)(a.in[12] + ch + 4), lb0 = *(const f32x4*)(a.in[13] + ch), lb1 = *(const f32x4*)(a.in[13] + ch + 4);
            if (!sample) {
                u32x4 wv[4];
#pragma unroll
                for (int i = 0; i < 4; ++i) { const int p = tid + NTHR * i; wv[i] = *(const u32x4*)(SW + g * 16384 + p * 8); }
#pragma unroll
                for (int ct = 0; ct < 8; ++ct) e0[ct] = *(const u32x2*)(zt + (8 + g) * ZBLK + t * 128 + ct * 16 + fq * 4);
#pragma unroll
                for (int i = 0; i < 4; ++i) { const int p = tid + NTHR * i, r = p >> 4, c = p & 15; *(LAS u32x4*)(Ys + r * LP + c * 8) = wv[i]; }
#pragma unroll
                for (int i = 0; i < 4; ++i) {
                    const int s_ = pr + 32 * i;
                    const float mu = st[i].x * (1.0f / 512.0f), rstd = rsqrtf(fmaxf(st[i].y * (1.0f / 512.0f) - mu * mu, 0.f) + 1e-6f);
                    f32x4 lo, hi; unpack8(vv[i], lo, hi);
                    const f32x4 vlo = (lo - mu) * rstd * lg0 + lb0, vhi = (hi - mu) * rstd * lg1 + lb1;
                    const u32x4 pk = pack8(vlo, vhi);
                    LAS bf16_t* xp = Xs + (pc * 8) * LP + ((((s_ >> 3) ^ pc) << 3) | (s_ & 7));
                    xp[0 * LP] = (bf16_t)(pk.x & 0xffffu); xp[1 * LP] = (bf16_t)(pk.x >> 16); xp[2 * LP] = (bf16_t)(pk.y & 0xffffu); xp[3 * LP] = (bf16_t)(pk.y >> 16);
                    xp[4 * LP] = (bf16_t)(pk.z & 0xffffu); xp[5 * LP] = (bf16_t)(pk.z >> 16); xp[6 * LP] = (bf16_t)(pk.w & 0xffffu); xp[7 * LP] = (bf16_t)(pk.w >> 16);
                    if (n == 15) { float* o = out + O_VP + ((size_t)(b * 128 + s_) * 512 + ch); *(f32x4*)o = vlo; *(f32x4*)(o + 4) = vhi; }
                }
            } else {
                const float w00 = a.in[14][g * 16384], sb0 = a.in[15][g * 128];
#pragma unroll
                for (int i = 0; i < 4; ++i) {
                    const int s_ = pr + 32 * i;
                    const float mu = st[i].x * (1.0f / 512.0f), rstd = rsqrtf(fmaxf(st[i].y * (1.0f / 512.0f) - mu * mu, 0.f) + 1e-6f);
                    f32x4 lo, hi; unpack8(vv[i], lo, hi);
                    const f32x4 vlo = (lo - mu) * rstd * lg0 + lb0, vhi = (hi - mu) * rstd * lg1 + lb1;
                    f32x4 ulo, uhi;
                    unpack8(*(const u32x4*)(zt + (8 + g) * ZBLK + s_ * 128 + pc * 8), ulo, uhi);
                    const f32x4 ylo = ulo * (vlo * w00 + sb0), yhi = uhi * (vhi * w00 + sb0);
                    *(u32x4*)(YAB + (size_t)(MPR + s_) * D + 512 + ch) = pack8(ylo, yhi);
                    float* o = out + O_VS + (size_t)s_ * 512 + ch; *(f32x4*)o = vlo; *(f32x4*)(o + 4) = vhi;
                }
            }
            __syncthreads();
            if (sample) continue;
        }
        f32x4 pbv[8], psv[8];
        if (!isB) {
#pragma unroll
            for (int ct = 0; ct < 8; ++ct) { pbv[ct] = *(const f32x4*)(a.in[10] + g * 128 + ct * 16 + fq * 4); psv[ct] = *(const f32x4*)(a.in[11] + g * 128 + ct * 16 + fq * 4); }
        }
        f32x4 acc[8];
#pragma unroll
        for (int ct = 0; ct < 8; ++ct) acc[ct] = (f32x4){0.f, 0.f, 0.f, 0.f};
        bf16x8 yf[4];
#pragma unroll
        for (int ks = 0; ks < 4; ++ks) yf[ks] = *(const LAS bf16x8*)(Ys + (wid * 16 + fr) * LP + ks * 32 + fq * 8);
#pragma unroll
        for (int ct = 0; ct < 8; ++ct)
#pragma unroll
            for (int ks = 0; ks < 4; ++ks) {
                const bf16x8 xf = *(const LAS bf16x8*)(Xs + (ct * 16 + fr) * LP + (((ks * 4 + fq) ^ (ct * 2 + (fr >> 3))) << 3));
                acc[ct] = __builtin_amdgcn_mfma_f32_16x16x32_bf16(xf, yf[ks], acc[ct], 0, 0, 0);
            }
        if (!isB) {
#pragma unroll
            for (int ct = 0; ct < 8; ++ct) {
                const int ch = g * 128 + ct * 16 + fq * 4;
                const f32x4 pb = pbv[ct], ps = psv[ct];
                const u32x2 gv = e0[ct];
                const f32x4 ga = (f32x4){bf_lo(gv.x), bf_hi(gv.x), bf_lo(gv.y), bf_hi(gv.y)};
                const f32x4 v = (acc[ct] + pb) * ps * ga;
                u32x2 wq; wq.x = pk_bf16(v[0], v[1]); wq.y = pk_bf16(v[2], v[3]);
                *(u32x2*)(YAB + row * D + ch) = wq;
            }
        } else {
            const float sbt = a.in[15][g * 128 + t];
#pragma unroll
            for (int ct = 0; ct < 8; ++ct) {
                const int ch = g * 128 + ct * 16 + fq * 4;
                const u32x2 uv = e0[ct];
                const f32x4 uu = (f32x4){bf_lo(uv.x), bf_hi(uv.x), bf_lo(uv.y), bf_hi(uv.y)};
                const f32x4 v = uu * (acc[ct] + sbt);
                u32x2 wq; wq.x = pk_bf16(v[0], v[1]); wq.y = pk_bf16(v[2], v[3]);
                *(u32x2*)(YAB + row * D + 512 + ch) = wq;
            }
        }
    }
}

#define P3_DECODE(it, tile_, g_, isB_) const int tile_ = ((it) >> 3) - 1, sub_##tile_ = (((it) & 7) + ((it) >> 3)) & 7, g_ = sub_##tile_ & 3; const bool isB_ = sub_##tile_ >= 4
#define P3_PREFETCH(it) do { \
        P3_DECODE(it, tl_, gg_, ib_); \
        const bf16_t* zz_ = Z + (size_t)tl_ * NCG * ZBLK; const int tt_ = wid * 16 + fr; \
        if (!ib_) { \
            _Pragma("unroll") for (int i = 0; i < 4; ++i) L[i] = *(const u32x4*)(PW + gg_ * 16384 + (tid + NTHR * i) * 8); \
            _Pragma("unroll") for (int i = 0; i < 5; ++i) { const int p = tid + NTHR * i; L[4 + i] = (u32x4){0u, 0u, 0u, 0u}; \
                if (p < 16 * 16) { if ((tl_ & 15) > 0) L[4 + i] = *(const u32x4*)(zz_ - (size_t)NCG * ZBLK + gg_ * ZBLK + (112 * 16 + p) * 8); } \
                else if (p < 144 * 16) L[4 + i] = *(const u32x4*)(zz_ + gg_ * ZBLK + (p - 256) * 8); } \
            _Pragma("unroll") for (int ct = 0; ct < 8; ++ct) E[ct] = *(const u32x2*)(zz_ + (4 + gg_) * ZBLK + tt_ * 128 + ct * 16 + fq * 4); \
        } else { \
            _Pragma("unroll") for (int i = 0; i < 4; ++i) { const int p = tid + NTHR * i; L[i] = *(const u32x4*)(zz_ + (12 + gg_) * ZBLK + p * 8); ST[i] = *(const f32x2*)(stats + (size_t)(tl_ * 128 + (p >> 4)) * 2); \
                L[4 + i] = *(const u32x4*)(SW + gg_ * 16384 + p * 8); } \
            _Pragma("unroll") for (int ct = 0; ct < 8; ++ct) E[ct] = *(const u32x2*)(zz_ + (8 + gg_) * ZBLK + tt_ * 128 + ct * 16 + fq * 4); \
        } } while (0)

__device__ __forceinline__ void p3_pipelined(const Args& a, LAS unsigned char* lds, int item0, int item_end, int item_step) {
    unsigned char* ws = a.ws;
    const bf16_t* Z = (const bf16_t*)(ws + WS_Z);
    bf16_t* YAB = (bf16_t*)(ws + WS_YAB);
    const bf16_t* PW = (const bf16_t*)(ws + WS_PW);
    const bf16_t* SW = (const bf16_t*)(ws + WS_SW);
    const float* stats = (const float*)(ws + WS_STATS);
    float* out = a.out;
    LAS bf16_t* Xs = (LAS bf16_t*)lds;
    LAS bf16_t* Ys = (LAS bf16_t*)(lds + 34816);
    LAS bf16_t* Es = (LAS bf16_t*)(lds + 69632);
    if (item0 >= item_end) return;
    u32x4 L[9]; u32x2 E[8]; f32x2 ST[4];
    {
        int tid_ = threadIdx.x; asm volatile("" : "+v"(tid_));
        const int tid = tid_, wid = tid >> 6, lane = tid & 63, fr = lane & 15, fq = lane >> 4;
        P3_PREFETCH(item0);
    }
    for (int item = item0; item < item_end; item += item_step) {
        int tid_ = threadIdx.x; asm volatile("" : "+v"(tid_));
        const int tid = tid_, wid = tid >> 6, lane = tid & 63, fr = lane & 15, fq = lane >> 4, pr = tid >> 4, pc = tid & 15;
        P3_DECODE(item, tile, g, isB);
        const int row0 = tile * 128, b = tile >> 4, n = tile & 15;
        const int t = wid * 16 + fr;
        const size_t row = (size_t)(row0 + t);
        __syncthreads();
        if (!isB) {
            const int w = 2 << g;
#pragma unroll
            for (int i = 0; i < 4; ++i) { const int p = tid + NTHR * i, r = p >> 4, c = p & 15; *(LAS u32x4*)(Xs + r * LP + ((c ^ ((r >> 3) & 15)) << 3)) = L[i]; }
#pragma unroll
            for (int i = 0; i < 5; ++i) { const int p = tid + NTHR * i, r = p >> 4, c = p & 15; if (p < 144 * 16) *(LAS u32x4*)(Es + r * LP + c * 8) = L[4 + i]; }
            __syncthreads();
            {
                f32x4 s_lo = (f32x4){0.f, 0.f, 0.f, 0.f}, s_hi = s_lo;
                for (int j = 1; j < w; ++j) {
                    f32x4 lo, hi; unpack8(*(const LAS u32x4*)(Es + (16 + pr * 4 - j) * LP + pc * 8), lo, hi);
                    s_lo += lo; s_hi += hi;
                }
#pragma unroll 1
                for (int i = 0; i < 4; ++i) {
                    const int tt = pr * 4 + i;
                    f32x4 a_lo, a_hi; unpack8(*(const LAS u32x4*)(Es + (16 + tt) * LP + pc * 8), a_lo, a_hi);
                    s_lo += a_lo; s_hi += a_hi;
                    const int cnt = min(n * 128 + tt + 1, w);
                    const float inv = 1.0f / (float)cnt;
                    *(LAS u32x4*)(Ys + tt * LP + pc * 8) = pack8(s_lo * inv - a_lo, s_hi * inv - a_hi);
                    if (n == 15 && tt >= 113) {
                        float* o = out + O_PP + ((size_t)(b * 15 + (tt - 113)) * 512 + g * 128 + pc * 8);
                        *(f32x4*)o = a_lo; *(f32x4*)(o + 4) = a_hi;
                    }
                    f32x4 d_lo, d_hi; unpack8(*(const LAS u32x4*)(Es + (16 + tt + 1 - w) * LP + pc * 8), d_lo, d_hi);
                    s_lo -= d_lo; s_hi -= d_hi;
                }
            }
        } else {
            const int ch = g * 128 + pc * 8;
            const f32x4 lg0 = *(const f32x4*)(a.in[12] + ch), lg1 = *(const f32x4*)(a.in[12] + ch + 4), lb0 = *(const f32x4*)(a.in[13] + ch), lb1 = *(const f32x4*)(a.in[13] + ch + 4);
#pragma unroll
            for (int i = 0; i < 4; ++i) { const int p = tid + NTHR * i, r = p >> 4, c = p & 15; *(LAS u32x4*)(Ys + r * LP + c * 8) = L[4 + i]; }
#pragma unroll
            for (int i = 0; i < 4; ++i) {
                const int s_ = pr + 32 * i;
                const float mu = ST[i].x * (1.0f / 512.0f), rstd = rsqrtf(fmaxf(ST[i].y * (1.0f / 512.0f) - mu * mu, 0.f) + 1e-6f);
                f32x4 lo, hi; unpack8(L[i], lo, hi);
                const f32x4 vlo = (lo - mu) * rstd * lg0 + lb0, vhi = (hi - mu) * rstd * lg1 + lb1;
                const u32x4 pk = pack8(vlo, vhi);
                LAS bf16_t* xp = Xs + (pc * 8) * LP + ((((s_ >> 3) ^ pc) << 3) | (s_ & 7));
                xp[0 * LP] = (bf16_t)(pk.x & 0xffffu); xp[1 * LP] = (bf16_t)(pk.x >> 16); xp[2 * LP] = (bf16_t)(pk.y & 0xffffu); xp[3 * LP] = (bf16_t)(pk.y >> 16);
                xp[4 * LP] = (bf16_t)(pk.z & 0xffffu); xp[5 * LP] = (bf16_t)(pk.z >> 16); xp[6 * LP] = (bf16_t)(pk.w & 0xffffu); xp[7 * LP] = (bf16_t)(pk.w >> 16);
                if (n == 15) { float* o = out + O_VP + ((size_t)(b * 128 + s_) * 512 + ch); *(f32x4*)o = vlo; *(f32x4*)(o + 4) = vhi; }
            }
        }
        __syncthreads();
        u32x2 Ec[8];
#pragma unroll
        for (int ct = 0; ct < 8; ++ct) Ec[ct] = E[ct];
        f32x4 pbv[8], psv[8]; float sbt = 0.f;
        if (!isB) {
#pragma unroll
            for (int ct = 0; ct < 8; ++ct) { pbv[ct] = *(const f32x4*)(a.in[10] + g * 128 + ct * 16 + fq * 4); psv[ct] = *(const f32x4*)(a.in[11] + g * 128 + ct * 16 + fq * 4); }
        } else sbt = a.in[15][g * 128 + t];
        if (item + item_step < item_end) P3_PREFETCH(item + item_step);
        f32x4 acc[8];
#pragma unroll
        for (int ct = 0; ct < 8; ++ct) acc[ct] = (f32x4){0.f, 0.f, 0.f, 0.f};
        bf16x8 yf[4];
#pragma unroll
        for (int ks = 0; ks < 4; ++ks) yf[ks] = *(const LAS bf16x8*)(Ys + (wid * 16 + fr) * LP + ks * 32 + fq * 8);
#pragma unroll
        for (int ct = 0; ct < 8; ++ct)
#pragma unroll
            for (int ks = 0; ks < 4; ++ks) {
                const bf16x8 xf = *(const LAS bf16x8*)(Xs + (ct * 16 + fr) * LP + (((ks * 4 + fq) ^ (ct * 2 + (fr >> 3))) << 3));
                acc[ct] = __builtin_amdgcn_mfma_f32_16x16x32_bf16(xf, yf[ks], acc[ct], 0, 0, 0);
            }
        if (!isB) {
#pragma unroll
            for (int ct = 0; ct < 8; ++ct) {
                const int ch = g * 128 + ct * 16 + fq * 4;
                const u32x2 gv = Ec[ct];
                const f32x4 ga = (f32x4){bf_lo(gv.x), bf_hi(gv.x), bf_lo(gv.y), bf_hi(gv.y)};
                const f32x4 v = (acc[ct] + pbv[ct]) * psv[ct] * ga;
                u32x2 wq; wq.x = pk_bf16(v[0], v[1]); wq.y = pk_bf16(v[2], v[3]);
                *(u32x2*)(YAB + row * D + ch) = wq;
            }
        } else {
#pragma unroll
            for (int ct = 0; ct < 8; ++ct) {
                const int ch = g * 128 + ct * 16 + fq * 4;
                const u32x2 uv = Ec[ct];
                const f32x4 uu = (f32x4){bf_lo(uv.x), bf_hi(uv.x), bf_lo(uv.y), bf_hi(uv.y)};
                const f32x4 v = uu * (acc[ct] + sbt);
                u32x2 wq; wq.x = pk_bf16(v[0], v[1]); wq.y = pk_bf16(v[2], v[3]);
                *(u32x2*)(YAB + row * D + 512 + ch) = wq;
            }
        }
    }
}
#undef P3_PREFETCH
#undef P3_DECODE

template <int MODE>
__device__ __forceinline__ void sample_gemm(const Args& a, LAS unsigned char* lds) {
    int tid_ = threadIdx.x; asm volatile("" : "+v"(tid_));
    const int tid = tid_, wid = tid >> 6, lane = tid & 63, fr = lane & 15, fq = lane >> 4, rtile = wid & 1, ks = wid >> 1;
    unsigned char* ws = a.ws;
    const bf16_t* A = MODE == 0 ? (const bf16_t*)(ws + WS_YAB) + (size_t)MPR * D : (const bf16_t*)(ws + WS_HB) + (size_t)MPR * D;
    const bf16_t* Wt = MODE == 0 ? (const bf16_t*)(ws + WS_WAB) : (const bf16_t*)(ws + WS_WO);
    LAS f32x4* red = (LAS f32x4*)lds;
    for (int item = BID; item < 256; item += gridDim.x) {
        const int rt = item & 3, ct = item >> 2;
        const bf16_t* ap = A + (size_t)(rt * 32 + rtile * 16 + fr) * D + ks * 256 + fq * 8;
        const bf16_t* wp = Wt + (size_t)(ct * 16 + fr) * D + ks * 256 + fq * 8;
        bf16x8 xa[8], xw[8];
#pragma unroll
        for (int s = 0; s < 8; ++s) { xa[s] = *(const bf16x8*)(ap + s * 32); xw[s] = *(const bf16x8*)(wp + s * 32); }
        const int row = rt * 32 + (wid & 1) * 16 + fr, col = ct * 16 + fq * 4;
        u32x2 esa = (u32x2){0u, 0u}, esb = esa; f32x4 exv = (f32x4){0.f, 0.f, 0.f, 0.f}, egv = exv;
        if (wid < 2) {
            if (MODE == 0) {
                const bf16_t* zr = (const bf16_t*)(ws + WS_Z) + ((size_t)128 * NCG + 20 + 2 * (col >> 7)) * ZBLK + row * 128 + (col & 127);
                esa = *(const u32x2*)(zr); esb = *(const u32x2*)(zr + ZBLK);
            } else {
                exv = *(const f32x4*)(a.in[1] + (size_t)row * D + col);
                egv = *(const f32x4*)((const float*)(ws + WS_GATE) + (size_t)(NB + row) * D + col);
            }
        }
        f32x4 acc = (f32x4){0.f, 0.f, 0.f, 0.f};
#pragma unroll
        for (int s = 0; s < 8; ++s) acc = __builtin_amdgcn_mfma_f32_16x16x32_bf16(xw[s], xa[s], acc, 0, 0, 0);
        __syncthreads();
        red[wid * 64 + lane] = acc;
        __syncthreads();
        if (wid < 2) {
            const f32x4 p0 = red[(0 + wid) * 64 + lane], p1 = red[(2 + wid) * 64 + lane], p2 = red[(4 + wid) * 64 + lane], p3 = red[(6 + wid) * 64 + lane];
            if (MODE == 0) {
                const f32x4 fa = (f32x4){bf_lo(esa.x), bf_hi(esa.x), bf_lo(esa.y), bf_hi(esa.y)}, fb = (f32x4){bf_lo(esb.x), bf_hi(esb.x), bf_lo(esb.y), bf_hi(esb.y)};
                const f32x4 v = fb * (fa * (p0 + p1) + (p2 + p3));
                u32x2 w; w.x = pk_bf16(v[0], v[1]); w.y = pk_bf16(v[2], v[3]);
                *(u32x2*)((bf16_t*)(ws + WS_HB) + (size_t)(MPR + row) * D + col) = w;
            } else {
                *(f32x4*)((float*)(ws + WS_XS) + (size_t)row * D + col) = exv + egv * ((p0 + p1) + (p2 + p3));
            }
        }
    }
    __syncthreads();
}

__global__ void __launch_bounds__(NTHR, 2) fwd_kernel(Args a) {
    extern __shared__ __attribute__((aligned(16))) unsigned char lds_raw[];
    LAS unsigned char* lds = (LAS unsigned char*)lds_raw;
    unsigned char* ws = a.ws;
    if (ws == nullptr) cg::this_grid().sync();
    if (threadIdx.x < 4) ((LAS unsigned*)(lds + LDS_BAR_OFF))[threadIdx.x] = 0u;
    __syncthreads();
    (void)xcd_barrier_post((unsigned*)(ws + WS_BAR), (volatile LAS unsigned*)(lds + LDS_BAR_OFF));
#define GRID_BAR() do { XcdBarrier b_; b_.bar = (unsigned*)(a.ws + WS_BAR); b_.x = xb_xcc_id(); b_.st = (volatile LAS unsigned*)(lds + LDS_BAR_OFF); xcd_barrier(b_); } while (0)

    p0_phase(a, lds);
    f32x4 xv[8][4]; float xr[8];
    p1_load(a, xv, xr);
    GRID_BAR();
    p1_phase(a, lds, xv, xr);
    GRID_BAR();
#pragma unroll 1
    for (int stage = 0; stage < 2; ++stage) {
        Gemm g{(const bf16_t*)(ws + WS_HB), (const bf16_t*)(ws + WS_WIN), MPAD, DIN, D, D / 64};
        OrderAB S{BID, stage};
        EpiZ E{(bf16_t*)(ws + WS_Z), (float*)(ws + WS_STATS)};
        gemm_phase<EpiZ, OrderAB>(lds, g, S, E);
        if (stage == 0) GRID_BAR();
    }
    {
        constexpr int NFREE = 256 - N_ORDER_B, N_FREE_ITEMS = 6 * NFREE;
        const bool fre = BID >= N_ORDER_B;
        int it0 = fre ? BID - N_ORDER_B : N_FREE_ITEMS + BID; const int itE = fre ? N_FREE_ITEMS : 129 * 8, itS = fre ? NFREE : N_ORDER_B;
        if (it0 < 8) { p3_phase(a, lds, it0, 8, itS); it0 += itS; }
        p3_pipelined(a, lds, it0, itE, itS);
    }
    GRID_BAR();
    {
        sample_gemm<0>(a, lds);
        Gemm g{(const bf16_t*)(ws + WS_YAB), (const bf16_t*)(ws + WS_WAB), MPR, D, D, 8};
        OrderK2 S; S.so.init(MPR, D, (int)gridDim.x, BID);
        EpiMerged E{(const bf16_t*)(ws + WS_Z), (bf16_t*)(ws + WS_HB)};
        gemm_phase<EpiMerged, OrderK2>(lds, g, S, E);
    }
    GRID_BAR();
    {
        sample_gemm<1>(a, lds);
        Gemm g{(const bf16_t*)(ws + WS_HB), (const bf16_t*)(ws + WS_WO), MPR, D, D, D / 64};
        StaticOrder S; S.init(MPR, D, (int)gridDim.x, BID);
        EpiFinal E{a.in[0], (const float*)(ws + WS_GATE), a.in[19], (float*)(ws + WS_RP), a.out + O_YP, (const float*)(ws + WS_XS), a.out + O_YS, (unsigned*)(ws + WS_BAR)};
        gemm_phase<EpiFinal, StaticOrder>(lds, g, S, E);
    }
}

extern "C" void kernel_launch(void* const* d_in, const int* in_sizes, int n_in, void* d_out, int out_size, void* d_ws, size_t ws_size, hipStream_t stream) {
    static int ready = 0;
    if (ready == 0) {
        ready = -1;
        if (n_in != 20 || in_sizes[0] != MPR * D || ws_size < WS_END) { fprintf(stderr, "kernel_launch: unexpected shapes (n_in %d, ws %zu, need %zu)\n", n_in, ws_size, (size_t)WS_END); return; }
        int dev = 0, cus = 0, per_cu = 0;
        if (hipGetDevice(&dev) != hipSuccess || hipDeviceGetAttribute(&cus, hipDeviceAttributeMultiprocessorCount, dev) != hipSuccess) { fprintf(stderr, "kernel_launch: device query failed\n"); return; }
        if (hipFuncSetAttribute((const void*)fwd_kernel, hipFuncAttributeMaxDynamicSharedMemorySize, LDS_BYTES) != hipSuccess) { fprintf(stderr, "kernel_launch: hipFuncSetAttribute failed\n"); return; }
        if (hipOccupancyMaxActiveBlocksPerMultiprocessor(&per_cu, (const void*)fwd_kernel, NTHR, LDS_BYTES) != hipSuccess) per_cu = 0;
        (void)hipGetLastError();
        if (cus * per_cu < 256) { fprintf(stderr, "kernel_launch: need 256 co-resident workgroups, device offers %d x %d\n", cus, per_cu); return; }
        ready = 1;
    }
    if (ready < 0) return;
    Args a{};
    for (int i = 0; i < 20; ++i) a.in[i] = (const float*)d_in[i];
    a.out = (float*)d_out; a.ws = (unsigned char*)d_ws;
    if (hipMemsetAsync((unsigned char*)d_ws + WS_BAR, 0, 16384, stream) != hipSuccess) { fprintf(stderr, "kernel_launch: memset failed\n"); return; }
    void* args[] = {&a};
    hipError_t e = hipLaunchCooperativeKernel((const void*)fwd_kernel, dim3(256), dim3(NTHR), args, LDS_BYTES, stream);
    if (e != hipSuccess) fprintf(stderr, "kernel_launch: cooperative launch failed: %s\n", hipGetErrorString(e));
}
```
